# Optimizing an MI355X kernel written in HIP

```python
import jax, jax.numpy as jnp
from jax import lax
import numpy as np

D_MODEL = 2048
BATCH = 8
SEQ = 2048
DEPTH = 4

GRID_W = 64
CTX_LEN = 256
N_MIXERS = 2
N_ATT_LAYERS = (DEPTH + 1) // 2
N_REC_LAYERS = DEPTH // 2
HEAD_DIM = 128
N_HEADS = D_MODEL // HEAD_DIM
N_KV_HEADS = 4
GQA_GROUP = N_HEADS // N_KV_HEADS
KV_DIM = N_KV_HEADS * HEAD_DIM
WINDOW = 128
ATT_BLOCK = 128
ROPE_BASE = 10000.0
REC_DK = 128
REC_HEADS = D_MODEL // REC_DK
REC_DV = D_MODEL // REC_HEADS
REC_CHUNK = 64
D_FF = 4 * D_MODEL
N_MOD = 6
NORM_EPS = 1e-6

kernel_name = "hybrid_swa_hgrn2_dit_trunk"


def rms_norm(x, g):
    x32 = x.astype(jnp.float32)
    y = x32 * lax.rsqrt(jnp.mean(x32 * x32, axis=-1, keepdims=True) + NORM_EPS)
    return (y * g.astype(jnp.float32)).astype(x.dtype)


def modulate(h, shift, scale):
    return h * (1 + scale) + shift


def axial_rope_tables(n_tokens):
    rows = n_tokens // GRID_W
    row = jnp.repeat(jnp.arange(rows), GRID_W).astype(jnp.float32)
    col = jnp.tile(jnp.arange(GRID_W), rows).astype(jnp.float32)
    quarter = HEAD_DIM // 4
    inv_freq = ROPE_BASE ** (-jnp.arange(quarter, dtype=jnp.float32) / quarter)
    ang_r = row[:, None] * inv_freq[None, :]
    ang_c = col[:, None] * inv_freq[None, :]
    ang = jnp.concatenate([ang_r, ang_r, ang_c, ang_c], axis=-1)
    return jnp.cos(ang), jnp.sin(ang)


def apply_axial_rope(x, cos, sin):
    x32 = x.astype(jnp.float32)
    xa = x32.reshape(x.shape[:-1] + (2, 2, HEAD_DIM // 4))
    rot = jnp.stack([-xa[..., 1, :], xa[..., 0, :]], axis=-2).reshape(x.shape)
    bshape = (x.shape[1],) + (1,) * (x.ndim - 3) + (HEAD_DIM,)
    return (x32 * cos.reshape(bshape) + rot * sin.reshape(bshape)).astype(x.dtype)


def windowed_gqa_attention(hx, hc, w_qkv, w_o, sink, cos, sin, need_ctx_out):
    B, T, _ = hx.shape
    L = hc.shape[1]
    nb = T // ATT_BLOCK
    scale = HEAD_DIM ** -0.5

    def split(h):
        p = h @ w_qkv
        n = h.shape[1]
        q = p[..., :D_MODEL].reshape(B, n, N_KV_HEADS, GQA_GROUP, HEAD_DIM)
        k = p[..., D_MODEL:D_MODEL + KV_DIM].reshape(B, n, N_KV_HEADS, HEAD_DIM)
        v = p[..., D_MODEL + KV_DIM:].reshape(B, n, N_KV_HEADS, HEAD_DIM)
        return q, k, v

    qx, kx, vx = split(hx)
    qc, kc, vc = split(hc)
    qx = apply_axial_rope(qx, cos, sin)
    kx = apply_axial_rope(kx, cos, sin)

    qb = qx.reshape(B, nb, ATT_BLOCK, N_KV_HEADS, GQA_GROUP, HEAD_DIM)

    def band(t):
        tp = jnp.pad(t, ((0, 0), (ATT_BLOCK, ATT_BLOCK), (0, 0), (0, 0)))
        tp = tp.reshape(B, nb + 2, ATT_BLOCK, N_KV_HEADS, HEAD_DIM)
        return jnp.concatenate([tp[:, :-2], tp[:, 1:-1], tp[:, 2:]], axis=2)

    kw, vw = band(kx), band(vx)
    qi = jnp.arange(ATT_BLOCK)[:, None]
    kj = jnp.arange(3 * ATT_BLOCK)[None, :]
    in_window = jnp.abs(kj - ATT_BLOCK - qi) <= WINDOW
    kpos = jnp.arange(nb)[:, None] * ATT_BLOCK - ATT_BLOCK + kj
    mask = in_window[None] & ((kpos >= 0) & (kpos < T))[:, None, :]

    s_w = jnp.einsum('bnqhgd,bnkhd->bnhgqk', qb, kw).astype(jnp.float32) * scale
    s_w = jnp.where(mask[None, :, None, None], s_w, -jnp.inf)
    s_c = jnp.einsum('bnqhgd,blhd->bnhgql', qb, kc).astype(jnp.float32) * scale
    sk = sink.astype(jnp.float32).reshape(1, 1, N_KV_HEADS, GQA_GROUP, 1, 1)
    m = jnp.maximum(jnp.maximum(s_w.max(-1, keepdims=True), s_c.max(-1, keepdims=True)), sk)
    p_w = jnp.exp(s_w - m)
    p_c = jnp.exp(s_c - m)
    inv = 1.0 / (p_w.sum(-1, keepdims=True) + p_c.sum(-1, keepdims=True) + jnp.exp(sk - m))
    p_w = (p_w * inv).astype(vw.dtype)
    p_c = (p_c * inv).astype(vc.dtype)
    o = jnp.einsum('bnhgqk,bnkhd->bnqhgd', p_w, vw) + jnp.einsum('bnhgql,blhd->bnqhgd', p_c, vc)
    ox = o.reshape(B, T, D_MODEL) @ w_o

    oc = None
    if need_ctx_out:
        s = jnp.einsum('blhgd,bmhd->bhglm', qc, kc).astype(jnp.float32) * scale
        skc = sink.astype(jnp.float32).reshape(1, N_KV_HEADS, GQA_GROUP, 1, 1)
        mc = jnp.maximum(s.max(-1, keepdims=True), skc)
        pc = jnp.exp(s - mc)
        pc = (pc / (pc.sum(-1, keepdims=True) + jnp.exp(skc - mc))).astype(vc.dtype)
        oc = jnp.einsum('bhglm,bmhd->blhgd', pc, vc).reshape(B, L, D_MODEL) @ w_o
    return ox, oc


def hgrn2_chunk_scan(q, k, v, log_f, s0):
    B, T, H, DK = q.shape
    nc = T // REC_CHUNK

    def to_chunks(a):
        return jnp.moveaxis(a.reshape((B, nc, REC_CHUNK) + a.shape[2:]), 1, 0)

    tril = jnp.tril(jnp.ones((REC_CHUNK, REC_CHUNK), dtype=bool))

    def step(s, inp):
        qc, kc, vc, gc = inp
        b = jnp.cumsum(gc, axis=1)
        o_inter = jnp.einsum('bchk,bhkv->bchv', qc * jnp.exp(b), s)
        diff = b[:, :, None] - b[:, None, :]
        decay = jnp.exp(jnp.where(tril[None, :, :, None, None], diff, -jnp.inf))
        a = jnp.einsum('btshk,bshk->bhts', decay * qc[:, :, None], kc)
        o_intra = jnp.einsum('bhts,bshv->bthv', a, vc)
        b_last = b[:, -1]
        s_new = jnp.exp(b_last)[..., None] * s + jnp.einsum(
            'bshk,bshv->bhkv', kc * jnp.exp(b_last[:, None] - b), vc)
        return s_new, o_inter + o_intra

    s_fin, o = lax.scan(step, s0, (to_chunks(q), to_chunks(k), to_chunks(v), to_chunks(log_f)))
    return jnp.moveaxis(o, 0, 1).reshape(B, T, H, v.shape[-1]), s_fin


def hgrn2_mixer(hx, hc, w_in, w_o, lb, onorm_g, need_ctx_out):
    B = hx.shape[0]

    def project(h):
        n = h.shape[1]
        p = (h @ w_in).astype(jnp.float32)
        q_raw, i_raw, f_fw, f_bw, g_raw = jnp.split(p, 5, axis=-1)
        shp = (B, n, REC_HEADS, REC_DK)
        q = jax.nn.silu(q_raw).reshape(shp)
        v = i_raw.reshape(B, n, REC_HEADS, REC_DV)

        def gates(z, lb_d):
            log_f = jnp.logaddexp(jnp.log(lb_d), jnp.log1p(-lb_d) + jax.nn.log_sigmoid(z))
            return (-jnp.expm1(log_f)).reshape(shp), log_f.reshape(shp)

        return q, v, gates(f_fw, lb[0]), gates(f_bw, lb[1]), g_raw

    def flip(a):
        return jnp.flip(a, axis=1)

    def bidir(q, v, fw, bw, s_fw, s_bw):
        o_f, sf = hgrn2_chunk_scan(q, fw[0], v, fw[1], s_fw)
        o_b, sb = hgrn2_chunk_scan(flip(q), flip(bw[0]), flip(v), flip(bw[1]), s_bw)
        return o_f + flip(o_b), sf, sb

    def readout(o, g, dtype):
        n = o.shape[1]
        o = rms_norm(o, onorm_g) * jax.nn.silu(g).reshape(o.shape)
        return o.reshape(B, n, D_MODEL).astype(dtype) @ w_o

    zero = jnp.zeros((B, REC_HEADS, REC_DK, REC_DV), jnp.float32)
    qc, vc, fwc, bwc, gc = project(hc)
    oc, sc_f, sc_b = bidir(qc, vc, fwc, bwc, zero, zero)
    qx, vx, fwx, bwx, gx = project(hx)
    ox, _, _ = bidir(qx, vx, fwx, bwx, sc_f, sc_b)
    ox = readout(ox, gx, hx.dtype)
    oc = readout(oc, gc, hc.dtype) if need_ctx_out else None
    return ox, oc


def squared_relu_mlp(h, w_up, w_down):
    u = jax.nn.relu(h @ w_up)
    return (u * u) @ w_down


def setup_inputs(seed: int = 0) -> dict:
    key = jax.random.key(seed)
    ks = jax.random.split(key, 18)

    def nrm(k, shape, s):
        return jax.random.normal(k, shape, jnp.float32) * s

    d = D_MODEL
    return {
        "x": nrm(ks[0], (BATCH, SEQ, d), 1.0),
        "c": nrm(ks[1], (BATCH, d), 1.0),
        "ctx": nrm(ks[2], (BATCH, CTX_LEN, d), 1.0),
        "c_ctx": nrm(ks[3], (d,), 1.0),
        "w_ada": nrm(ks[4], (DEPTH, d, N_MOD * d), 0.5 * d ** -0.5),
        "b_ada": nrm(ks[5], (DEPTH, N_MOD * d), 0.01),
        "norm_mix_g": 1.0 + nrm(ks[6], (DEPTH, d), 0.02),
        "norm_mlp_g": 1.0 + nrm(ks[7], (DEPTH, d), 0.02),
        "att_w_qkv": nrm(ks[8], (N_ATT_LAYERS, d, d + 2 * KV_DIM), d ** -0.5),
        "att_w_o": nrm(ks[9], (N_ATT_LAYERS, d, d), d ** -0.5),
        "att_sink": nrm(ks[10], (N_ATT_LAYERS, N_HEADS), 0.5),
        "rec_w_in": nrm(ks[11], (N_REC_LAYERS, d, 5 * d), d ** -0.5),
        "rec_w_o": nrm(ks[12], (N_REC_LAYERS, d, d), d ** -0.5),
        "rec_lb_logits": nrm(ks[13], (N_REC_LAYERS, 2, d), 0.5),
        "rec_onorm_g": 1.0 + nrm(ks[14], (N_REC_LAYERS, REC_DV), 0.02),
        "mlp_w_up": nrm(ks[15], (DEPTH, d, D_FF), d ** -0.5),
        "mlp_w_down": nrm(ks[16], (DEPTH, D_FF, d), D_FF ** -0.5),
        "final_norm_g": 1.0 + nrm(ks[17], (d,), 0.02),
    }


def reference(x, c, ctx, c_ctx, w_ada, b_ada, norm_mix_g, norm_mlp_g, att_w_qkv, att_w_o, att_sink,
              rec_w_in, rec_w_o, rec_lb_logits, rec_onorm_g, mlp_w_up, mlp_w_down, final_norm_g):
    T = x.shape[1]
    cos, sin = axial_rope_tables(T)
    gam = jax.nn.softmax(rec_lb_logits.astype(jnp.float32), axis=0)
    lower_bounds = jnp.cumsum(gam, axis=0) - gam[0:1]
    silu_c = jax.nn.silu(c)
    silu_cc = jax.nn.silu(c_ctx)

    for i in range(DEPTH):
        last = i == DEPTH - 1
        j = i // N_MIXERS
        mx = jnp.split(silu_c @ w_ada[i] + b_ada[i], N_MOD, axis=-1)
        mc = jnp.split(silu_cc @ w_ada[i] + b_ada[i], N_MOD, axis=-1)
        hx = modulate(rms_norm(x, norm_mix_g[i]), mx[0][:, None], mx[1][:, None])
        hc = modulate(rms_norm(ctx, norm_mix_g[i]), mc[0], mc[1])
        if i % N_MIXERS == 0:
            dx, dc = windowed_gqa_attention(hx, hc, att_w_qkv[j], att_w_o[j], att_sink[j], cos, sin, not last)
        else:
            dx, dc = hgrn2_mixer(hx, hc, rec_w_in[j], rec_w_o[j], lower_bounds[j], rec_onorm_g[j], not last)
        x = x + mx[2][:, None] * dx
        hx = modulate(rms_norm(x, norm_mlp_g[i]), mx[3][:, None], mx[4][:, None])
        x = x + mx[5][:, None] * squared_relu_mlp(hx, mlp_w_up[i], mlp_w_down[i])
        if not last:
            ctx = ctx + mc[2] * dc
            hc = modulate(rms_norm(ctx, norm_mlp_g[i]), mc[3], mc[4])
            ctx = ctx + mc[5] * squared_relu_mlp(hc, mlp_w_up[i], mlp_w_down[i])

    return rms_norm(x, final_norm_g)
```

```cpp
#include <hip/hip_runtime.h>
#include <cstdio>
#include <cstdint>
#include <cmath>

namespace pg8 {
#define PG8_LAS __attribute__((address_space(3)))
typedef unsigned short bf16_t;
typedef short bf16x8 __attribute__((ext_vector_type(8)));
typedef float f32x4 __attribute__((ext_vector_type(4)));
typedef unsigned u32x4 __attribute__((ext_vector_type(4)));
constexpr int BM = 256, BK = 64, HALF = 128, HTB = HALF * BK * 2  , STAGE_BYTES = 8 * HTB, NXCD = 8, WGM = 8;

__host__ __device__ __forceinline__ int lds_byte(int r, int c) { const int st = (r >> 4) * 2 + (c >> 5), rr = r & 15, cc = c & 31, ob = rr * 64 + cc * 2; return st * 1024 + (ob ^ (((ob >> 9) & 1) << 5)); }
__host__ __device__ __forceinline__ void stage_rc(int b, int& R, int& C) { const int st = b / 1024, sb = b % 1024, swz = sb ^ (((sb >> 9) & 1) << 5); R = (st >> 1) * 16 + swz / 64; C = (st & 1) * 32 + (swz % 64) / 2; }
__host__ __device__ __forceinline__ int perm32(int rho) { const int n = rho >> 4, i = rho & 15; return 8 * (i >> 2) + 4 * n + (i & 3); }

struct Unit { int pm, pn; };
struct Gemm { const bf16_t* A; const bf16_t* Bt; int M, N, K; };

struct StaticOrder {
    int nM, nN, nwg, G, c;
    __host__ __device__ void init(int M, int N, int G_, int c_) { nM = M / BM; nN = N / BM; nwg = nM * nN; G = G_; c = c_; }
    __host__ __device__ bool next(int i, Unit& u) const {
        const long L = (long)i * G + c; if (L >= nwg) return false;
        int wgid = (int)L; { const int q = nwg / NXCD, r = nwg % NXCD, xcd = wgid % NXCD, off = wgid / NXCD; wgid = (xcd < r ? xcd * (q + 1) : r * (q + 1) + (xcd - r) * q) + off; }
        const int nig = WGM * nN, gid = wgid / nig, fm = gid * WGM, gsz = (nM - fm) < WGM ? (nM - fm) : WGM;
        u.pm = fm + ((wgid % nig) % gsz); u.pn = (wgid % nig) / gsz; return true;
    }
    __device__ __forceinline__ void a_ready(const Unit&) const {}
    __device__ __forceinline__ void done(const Unit&) const {}
};


__device__ __forceinline__ unsigned cvt_pk_bf16(float lo, float hi) { unsigned r; asm volatile("v_cvt_pk_bf16_f32 %0, %1, %2" : "=v"(r) : "v"(lo), "v"(hi)); return r; }
__device__ __forceinline__ float fast_sigmoid(float x) { return __builtin_amdgcn_rcpf(1.0f + __expf(-x)); }
__device__ __forceinline__ float fast_silu(float x) { return x * fast_sigmoid(x); }

constexpr int E_ML = 16384;
constexpr int E_DM = 2048, E_NMOD = 12288;

struct EpiRes {
    static constexpr bool PERM = false, AFTER_DRAIN = false;
    const float* base_lat; const float* base_ctx; float* out; const float* gate;
    __device__ __forceinline__ void operator()(const f32x4 (&acc)[2][2][4][2], const Unit& u, int wr, int wc, int fr, int fq) const {
        const int row0 = u.pm * BM + wr * 64 + fr, col0 = u.pn * BM + wc * 32 + 4 * fq;
        const bool lat = u.pm < (E_ML / BM);
        const int r9 = lat ? (u.pm >> 3) : 8;
        const float* gp = gate + (size_t)r9 * E_NMOD + col0;
        f32x4 gv[2][2];
#pragma unroll
        for (int bj = 0; bj < 2; ++bj)
#pragma unroll
            for (int n = 0; n < 2; ++n) gv[bj][n] = *(const f32x4*)(gp + bj * HALF + n * 16);
        const float* bp = lat ? base_lat + (size_t)row0 * E_DM + col0 : base_ctx + (size_t)(row0 - E_ML) * E_DM + col0;
        float* op = out + (size_t)row0 * E_DM + col0;
#pragma unroll
        for (int ai = 0; ai < 2; ++ai)
#pragma unroll
            for (int m = 0; m < 4; ++m) { const size_t off = (size_t)(ai * HALF + m * 16) * E_DM;
#pragma unroll
                for (int bj = 0; bj < 2; ++bj)
#pragma unroll
                    for (int n = 0; n < 2; ++n) { const f32x4 bs = *(const f32x4*)(bp + off + bj * HALF + n * 16);
                        *(f32x4*)(op + off + bj * HALF + n * 16) = bs + gv[bj][n] * acc[ai][bj][m][n]; }
                if (m & 1) asm volatile("" ::: "memory"); }
    }
};
struct EpiUp {
    static constexpr bool PERM = true, AFTER_DRAIN = false;
    bf16_t* O; int ldc;
    __device__ __forceinline__ void operator()(const f32x4 (&acc)[2][2][4][2], const Unit& u, int wr, int wc, int fr, int fq) const {
        const int row0 = u.pm * BM + wr * 64 + fr, col0 = u.pn * BM + wc * 32 + 8 * fq;
#pragma unroll
        for (int ai = 0; ai < 2; ++ai)
#pragma unroll
            for (int m = 0; m < 4; ++m) { bf16_t* rowp = O + (size_t)(row0 + ai * HALF + m * 16) * ldc + col0;
#pragma unroll
                for (int bj = 0; bj < 2; ++bj) { f32x4 v0 = acc[ai][bj][m][0], v1 = acc[ai][bj][m][1];
#pragma unroll
                    for (int j = 0; j < 4; ++j) { const float a = fmaxf(v0[j], 0.f), b = fmaxf(v1[j], 0.f); v0[j] = a * a; v1[j] = b * b; }
                    u32x4 w; w.x = cvt_pk_bf16(v0[0], v0[1]); w.y = cvt_pk_bf16(v0[2], v0[3]); w.z = cvt_pk_bf16(v1[0], v1[1]); w.w = cvt_pk_bf16(v1[2], v1[3]);
                    *(u32x4*)(rowp + bj * HALF) = w; } }
    }
};
struct EpiQkv {
    static constexpr bool PERM = true, AFTER_DRAIN = false;
    bf16_t* O; const float* cosT; const float* sinT;
    __device__ __forceinline__ void operator()(const f32x4 (&acc)[2][2][4][2], const Unit& u, int wr, int wc, int fr, int fq) const {
        const int row0 = u.pm * BM + wr * 64 + fr, col0 = u.pn * BM + wc * 32 + 8 * fq;
        const bool rope = (u.pn < 10) && (u.pm < (E_ML / BM));
        const int axis = wc >> 1, i0 = ((wc & 1) * 4 + fq) * 4;
#pragma unroll
        for (int ai = 0; ai < 2; ++ai)
#pragma unroll
            for (int m = 0; m < 4; ++m) { const int row = row0 + ai * HALF + m * 16; bf16_t* rowp = O + (size_t)row * 3072 + col0;
                f32x4 c4 = (f32x4){1.f, 1.f, 1.f, 1.f}, s4 = (f32x4){0.f, 0.f, 0.f, 0.f};
                if (rope) { const int t = row & 2047; const int pos = axis ? (t & 63) : (t >> 6); c4 = *(const f32x4*)(cosT + pos * 32 + i0); s4 = *(const f32x4*)(sinT + pos * 32 + i0); }
#pragma unroll
                for (int bj = 0; bj < 2; ++bj) { const f32x4 v0 = acc[ai][bj][m][0], v1 = acc[ai][bj][m][1];
                    const f32x4 o0 = v0 * c4 - v1 * s4, o1 = v1 * c4 + v0 * s4;
                    u32x4 w; w.x = cvt_pk_bf16(o0[0], o0[1]); w.y = cvt_pk_bf16(o0[2], o0[3]); w.z = cvt_pk_bf16(o1[0], o1[1]); w.w = cvt_pk_bf16(o1[2], o1[3]);
                    *(u32x4*)(rowp + bj * HALF) = w; } }
    }
};
struct EpiRec {
    static constexpr bool PERM = true, AFTER_DRAIN = false;
    bf16_t* RQ; bf16_t* RV; bf16_t* RG; float* LF; const float* LB; size_t lf_stride;
    __device__ __forceinline__ void operator()(const f32x4 (&acc)[2][2][4][2], const Unit& u, int wr, int wc, int fr, int fq) const {
        const int seg = u.pn >> 3;
        const int row0 = u.pm * BM + wr * 64 + fr, col0 = (u.pn & 7) * BM + wc * 32 + 8 * fq;
        if (seg == 2 || seg == 3) {
            const int dir = seg - 2; float* base = LF + (size_t)dir * lf_stride;
            f32x4 lb[2][2];
#pragma unroll
            for (int bj = 0; bj < 2; ++bj)
#pragma unroll
                for (int n = 0; n < 2; ++n) lb[bj][n] = *(const f32x4*)(LB + dir * E_DM + col0 + bj * HALF + 4 * n);
#pragma unroll
            for (int ai = 0; ai < 2; ++ai)
#pragma unroll
                for (int m = 0; m < 4; ++m) { float* rowp = base + (size_t)(row0 + ai * HALF + m * 16) * E_DM + col0;
#pragma unroll
                    for (int bj = 0; bj < 2; ++bj)
#pragma unroll
                        for (int n = 0; n < 2; ++n) { const f32x4 z = acc[ai][bj][m][n]; f32x4 o;
#pragma unroll
                            for (int j = 0; j < 4; ++j) { const float l = lb[bj][n][j]; const float sg = fast_sigmoid(fmaxf(z[j], -80.f)); o[j] = __logf(l + (1.0f - l) * sg); }
                            *(f32x4*)(rowp + bj * HALF + 4 * n) = o; } }
        } else {
            bf16_t* O = RQ + (size_t)(seg == 4 ? 2 : seg) * ((size_t)72 << 19);
            const bool act = seg != 1;
#pragma unroll
            for (int ai = 0; ai < 2; ++ai)
#pragma unroll
                for (int m = 0; m < 4; ++m) { bf16_t* rowp = O + (size_t)(row0 + ai * HALF + m * 16) * E_DM + col0;
#pragma unroll
                    for (int bj = 0; bj < 2; ++bj) { f32x4 v0 = acc[ai][bj][m][0], v1 = acc[ai][bj][m][1];
                        if (act) {
#pragma unroll
                            for (int j = 0; j < 4; ++j) { v0[j] = fast_silu(v0[j]); v1[j] = fast_silu(v1[j]); } }
                        u32x4 w; w.x = cvt_pk_bf16(v0[0], v0[1]); w.y = cvt_pk_bf16(v0[2], v0[3]); w.z = cvt_pk_bf16(v1[0], v1[1]); w.w = cvt_pk_bf16(v1[2], v1[3]);
                        *(u32x4*)(rowp + bj * HALF) = w; } }
        }
    }
};


template <class Epi, class Sched, bool ALIGN_EPI = false, bool SP2 = false>
__device__ __forceinline__ void gemm_phase(PG8_LAS unsigned char* lds, const Gemm g, const Sched& S, const Epi& E) {
    int tid_o = threadIdx.x; asm volatile("" : "+v"(tid_o));
    const int tid = tid_o, wid = __builtin_amdgcn_readfirstlane(tid >> 6), lane = tid & 63, wr = wid >> 2, wc = wid & 3, fr = lane & 15, fq = lane >> 4;
    const int K = g.K, nt = K / BK;
    unsigned voffA[2], voffB[2];
#pragma unroll
    for (int i = 0; i < 2; ++i) { int R, C; stage_rc(tid * 16 + i * 8192, R, C); const int Rb = Epi::PERM ? ((R & ~31) + perm32(R & 31)) : R;
        voffA[i] = (unsigned)(R * K + C) * 2u; voffB[i] = (unsigned)(Rb * K + C) * 2u; }
    const size_t kstep = (size_t)(BK * 2);
    const size_t hstep = (size_t)HALF * K * 2;
    const size_t tstep = 2 * hstep;
    const unsigned ldsw = (unsigned)wid * 1024u;
    const int aoff = lds_byte(wr * 64 + fr, fq * 8), boff = lds_byte(wc * 32 + fr, fq * 8);
#define PG8_SA(b, h) (((b) * 2 + (h)) * HTB)
#define PG8_SB(b, h) ((4 + (b) * 2 + (h)) * HTB)
#define PG8_STAGE(bufoff, gbase, voff) do { _Pragma("unroll") for (int _i = 0; _i < 2; ++_i) \
        __builtin_amdgcn_global_load_lds((const unsigned*)((const char*)(gbase) + (voff)[_i]), (PG8_LAS unsigned*)(lds + (bufoff) + ldsw + _i * 8192), 16, 0, 0); } while (0)
#define PG8_LDA(dst, b, h) do { _Pragma("unroll") for (int m = 0; m < 4; ++m) _Pragma("unroll") for (int k = 0; k < 2; ++k) dst[m][k] = *(const PG8_LAS bf16x8*)(lds + PG8_SA(b, h) + aoff + m * 2048 + k * 1024); } while (0)
#define PG8_LDB(dst, b, h) do { _Pragma("unroll") for (int n = 0; n < 2; ++n) _Pragma("unroll") for (int k = 0; k < 2; ++k) dst[n][k] = *(const PG8_LAS bf16x8*)(lds + PG8_SB(b, h) + boff + n * 2048 + k * 1024); } while (0)
#define PG8_MMA(ai, bj, At, Bt) do { __builtin_amdgcn_s_setprio(1); _Pragma("unroll") for (int m = 0; m < 4; ++m) _Pragma("unroll") for (int n = 0; n < 2; ++n) _Pragma("unroll") for (int k = 0; k < 2; ++k) \
        acc[ai][bj][m][n] = __builtin_amdgcn_mfma_f32_16x16x32_bf16(Bt[n][k], At[m][k], acc[ai][bj][m][n], 0, 0, 0); __builtin_amdgcn_s_setprio(0); } while (0)
#define PG8_WAIT_V(n) asm volatile("s_waitcnt vmcnt(" #n ")" ::: "memory")
#define PG8_WAIT_L(n) asm volatile("s_waitcnt lgkmcnt(" #n ")" ::: "memory")
#define PG8_BAR __builtin_amdgcn_s_barrier()
#define PG8_SCHED __builtin_amdgcn_sched_barrier(0)
    Unit cur, nxt; int ui = 0;
    if (!S.next(0, cur)) return;
    f32x4 acc[2][2][4][2];
#pragma unroll
    for (int a = 0; a < 2; ++a)
#pragma unroll
        for (int b = 0; b < 2; ++b)
#pragma unroll
            for (int m = 0; m < 4; ++m)
#pragma unroll
                for (int n = 0; n < 2; ++n) acc[a][b][m][n] = (f32x4){0.f, 0.f, 0.f, 0.f};
    bf16x8 At[4][2], B0[2][2], B1[2][2];
    const char* cA = (const char*)g.A + (size_t)cur.pm * tstep; const char* cB = (const char*)g.Bt + (size_t)cur.pn * tstep;
    S.a_ready(cur);
    if constexpr (SP2) {
        PG8_STAGE(PG8_SB(0, 0), cB, voffB); PG8_STAGE(PG8_SB(0, 1), cB + hstep, voffB); PG8_STAGE(PG8_SA(0, 0), cA, voffA); PG8_STAGE(PG8_SA(0, 1), cA + hstep, voffA);
        if (wr == 1) PG8_BAR;
        PG8_WAIT_V(2); PG8_BAR;
        PG8_STAGE(PG8_SB(1, 0), cB + kstep, voffB); PG8_STAGE(PG8_SA(1, 0), cA + kstep, voffA); PG8_STAGE(PG8_SB(1, 1), cB + hstep + kstep, voffB);
        PG8_WAIT_V(6); PG8_BAR;
    } else {
        PG8_STAGE(PG8_SB(0, 0), cB, voffB); PG8_STAGE(PG8_SA(0, 0), cA, voffA); PG8_STAGE(PG8_SB(0, 1), cB + hstep, voffB); PG8_STAGE(PG8_SA(0, 1), cA + hstep, voffA);
        if (wr == 1) PG8_BAR;
        PG8_WAIT_V(4); PG8_BAR;
        PG8_STAGE(PG8_SB(1, 0), cB + kstep, voffB); PG8_STAGE(PG8_SA(1, 0), cA + kstep, voffA); PG8_STAGE(PG8_SB(1, 1), cB + hstep + kstep, voffB);
        PG8_WAIT_V(6); PG8_BAR;
    }
    for (;;) {
        const bool has_next = S.next(ui + 1, nxt);
        const char* nA = has_next ? (const char*)g.A + (size_t)nxt.pm * tstep : cA; const char* nB = has_next ? (const char*)g.Bt + (size_t)nxt.pn * tstep : cB;
        for (int t = 0; t < nt; t += 2) {
            const bool last = (t == nt - 2);
            const char* a1 = cA + (size_t)(t + 1) * kstep;
            const char* a2 = last ? nA : cA + (size_t)(t + 2) * kstep; const char* b2 = last ? nB : cB + (size_t)(t + 2) * kstep;
            const char* a3 = a2 + kstep; const char* b3 = b2 + kstep;
            if (last && has_next) S.a_ready(nxt);
            if constexpr (SP2) {
            PG8_LDB(B0, 0, 0); PG8_LDB(B1, 0, 1); PG8_SCHED; PG8_LDA(At, 0, 0); PG8_STAGE(PG8_SA(1, 1), a1 + hstep, voffA);
            PG8_WAIT_V(8); PG8_WAIT_L(0); PG8_BAR; PG8_MMA(0, 0, At, B0); PG8_MMA(0, 1, At, B1); PG8_BAR; PG8_SCHED;
            PG8_LDA(At, 0, 1); PG8_STAGE(PG8_SB(0, 0), b2, voffB); PG8_STAGE(PG8_SB(0, 1), b2 + hstep, voffB); PG8_STAGE(PG8_SA(0, 0), a2, voffA);
            PG8_WAIT_V(8); PG8_WAIT_L(0); PG8_BAR; PG8_MMA(1, 0, At, B0); PG8_MMA(1, 1, At, B1); PG8_BAR; PG8_SCHED;
            PG8_LDB(B0, 1, 0); PG8_LDB(B1, 1, 1); PG8_SCHED; PG8_LDA(At, 1, 0); PG8_STAGE(PG8_SA(0, 1), a2 + hstep, voffA);
            PG8_WAIT_V(8); PG8_WAIT_L(0); PG8_BAR; PG8_MMA(0, 0, At, B0); PG8_MMA(0, 1, At, B1); PG8_BAR; PG8_SCHED;
            PG8_LDA(At, 1, 1); PG8_STAGE(PG8_SB(1, 0), b3, voffB); PG8_STAGE(PG8_SB(1, 1), b3 + hstep, voffB); PG8_STAGE(PG8_SA(1, 0), a3, voffA);
            PG8_WAIT_V(8); PG8_WAIT_L(0); PG8_BAR; PG8_MMA(1, 0, At, B0); PG8_MMA(1, 1, At, B1); PG8_BAR; PG8_SCHED;
            } else {
            PG8_LDB(B0, 0, 0); PG8_SCHED; PG8_LDA(At, 0, 0); PG8_STAGE(PG8_SA(1, 1), a1 + hstep, voffA);
            PG8_WAIT_L(8); PG8_BAR; PG8_WAIT_L(0); PG8_MMA(0, 0, At, B0); PG8_BAR; PG8_SCHED;
            PG8_LDB(B1, 0, 1); PG8_STAGE(PG8_SB(0, 0), b2, voffB);
            PG8_BAR; PG8_WAIT_L(0); PG8_MMA(0, 1, At, B1); PG8_BAR;
            PG8_LDA(At, 0, 1); PG8_STAGE(PG8_SA(0, 0), a2, voffA);
            PG8_BAR; PG8_WAIT_L(0); PG8_MMA(1, 0, At, B0); PG8_BAR; PG8_SCHED;
            PG8_STAGE(PG8_SB(0, 1), b2 + hstep, voffB);
            PG8_WAIT_V(6); PG8_BAR; PG8_MMA(1, 1, At, B1); PG8_BAR;
            PG8_LDB(B0, 1, 0); PG8_SCHED; PG8_LDA(At, 1, 0); PG8_STAGE(PG8_SA(0, 1), a2 + hstep, voffA);
            PG8_WAIT_L(8); PG8_BAR; PG8_WAIT_L(0); PG8_MMA(0, 0, At, B0); PG8_BAR; PG8_SCHED;
            PG8_LDB(B1, 1, 1); PG8_STAGE(PG8_SB(1, 0), b3, voffB);
            PG8_BAR; PG8_WAIT_L(0); PG8_MMA(0, 1, At, B1); PG8_BAR;
            PG8_LDA(At, 1, 1); PG8_STAGE(PG8_SA(1, 0), a3, voffA);
            PG8_BAR; PG8_WAIT_L(0); PG8_MMA(1, 0, At, B0); PG8_BAR; PG8_SCHED;
            PG8_STAGE(PG8_SB(1, 1), b3 + hstep, voffB);
            PG8_WAIT_V(6); PG8_BAR; PG8_MMA(1, 1, At, B1); PG8_BAR;
            }
        }
        if constexpr (ALIGN_EPI) { if (wr == 0) PG8_BAR; }
        if constexpr (!Epi::AFTER_DRAIN) { E(acc, cur, wr, wc, fr, fq); S.done(cur); }
        if (!has_next) break;
#pragma unroll
        for (int a = 0; a < 2; ++a)
#pragma unroll
            for (int b = 0; b < 2; ++b)
#pragma unroll
                for (int m = 0; m < 4; ++m)
#pragma unroll
                    for (int n = 0; n < 2; ++n) acc[a][b][m][n] = (f32x4){0.f, 0.f, 0.f, 0.f};
        cur = nxt; cA = nA; cB = nB; ++ui;
        if constexpr (ALIGN_EPI) { if (wr == 1) PG8_BAR; }
    }
    PG8_WAIT_V(0);
    if constexpr (!ALIGN_EPI) { if (wr == 0) PG8_BAR; }
    PG8_BAR;
    if constexpr (Epi::AFTER_DRAIN) { E.fused(acc, cur, wr, wc, fr, fq, lds, wid, lane); S.done(cur); }
#undef PG8_SA
#undef PG8_SB
#undef PG8_STAGE
#undef PG8_LDA
#undef PG8_LDB
#undef PG8_MMA
#undef PG8_WAIT_V
#undef PG8_WAIT_L
#undef PG8_BAR
#undef PG8_SCHED
}
}

#define GAS __attribute__((address_space(1)))
#define LAS __attribute__((address_space(3)))
typedef unsigned short bf16;
typedef unsigned v4u __attribute__((ext_vector_type(4)));
typedef float f32x4 __attribute__((ext_vector_type(4)));
typedef short bf16x8 __attribute__((ext_vector_type(8)));
typedef GAS unsigned gu32;
typedef GAS unsigned long long gu64;
#define RLX_AGENT __ATOMIC_RELAXED, __HIP_MEMORY_SCOPE_AGENT
#define LDS_WAIT() asm volatile("s_waitcnt lgkmcnt(0)" ::: "memory")
#define VM_WAIT() asm volatile("s_waitcnt vmcnt(0)" ::: "memory")
__device__ __forceinline__ unsigned long long rt() { return __builtin_amdgcn_s_memrealtime(); }
__device__ __forceinline__ unsigned f2bf(float f) { unsigned u = __builtin_bit_cast(unsigned, f); return (u + 0x7fffu + ((u >> 16) & 1u)) >> 16; }
__device__ __forceinline__ unsigned pk2(float lo, float hi) { return f2bf(lo) | (f2bf(hi) << 16); }

#define XB_TMO      128
#define XB_XCNT(j)  (256  + 64 * (j))
#define XB_XSUB(j)  (1280 + 64 * (j))
#define XB_XGEN(j)  (2304 + 64 * (j))
#define XB_TOP      3328
#define XB_TOPGEN   3392
#define XCD_BAR_WORDS 3456
#define XB_SPIN_CAP (1u << 18)

__device__ __forceinline__ unsigned xb_ld(unsigned* p)              { return __hip_atomic_load(p, __ATOMIC_RELAXED, __HIP_MEMORY_SCOPE_AGENT); }
__device__ __forceinline__ unsigned xb_add(unsigned* p, unsigned v) { return __hip_atomic_fetch_add(p, v, __ATOMIC_RELAXED, __HIP_MEMORY_SCOPE_AGENT); }
__device__ __forceinline__ unsigned xb_xcc_id() { return (unsigned)__builtin_amdgcn_s_getreg((3 << 11) | 20) & 0xFu; }
#define XB_SPIN(cond, bar) do { unsigned _sp = 0; while (cond) { __builtin_amdgcn_s_sleep(1); \
    if ((++_sp & 255u) == 0u) { if (xb_ld(&(bar)[XB_TMO])) break; if (_sp > XB_SPIN_CAP) { atomicAdd(&(bar)[XB_TMO], 1u); break; } } } } while (0)

struct XcdBarrier {
    unsigned* bar; unsigned x;
    volatile LAS unsigned* st;
};

__device__ __forceinline__ XcdBarrier xcd_barrier_post(unsigned* bar, volatile LAS unsigned* st) {
    XcdBarrier b; b.bar = bar; b.x = xb_xcc_id(); b.st = st;
    if (threadIdx.x == 0) (void)xb_add(&bar[XB_XCNT(b.x)], 1u);
    return b;
}
__device__ __forceinline__ void xcd_barrier_complete(unsigned* bar, unsigned x, unsigned& nloc, unsigned& nx) {
    const unsigned G = gridDim.x * gridDim.y * gridDim.z;
    unsigned sum, cnt, mine, sp = 0u;
    for (;;) {
        sum = 0u; cnt = 0u; mine = 0u;
#pragma unroll
        for (unsigned j = 0; j < 16; ++j) { const unsigned c = xb_ld(&bar[XB_XCNT(j)]); sum += c; cnt += (c > 0u) ? 1u : 0u; mine = (j == x) ? c : mine; }
        if (sum == G) break;
        __builtin_amdgcn_s_sleep(1);
        if ((++sp & 255u) == 0u) { if (xb_ld(&bar[XB_TMO])) break; if (sp > XB_SPIN_CAP) { atomicAdd(&bar[XB_TMO], 1u); break; } }
    }
    nloc = mine > 0u ? mine : 1u; nx = cnt > 0u ? cnt : 1u;
}

__device__ __forceinline__ void xcd_barrier(const XcdBarrier& b) {
    asm volatile("s_waitcnt vmcnt(0)" ::: "memory");
    __syncthreads();
    if (threadIdx.x == 0) {
        unsigned* bar = b.bar;
        __builtin_amdgcn_s_waitcnt(0);
        unsigned nloc = b.st[0], nx = b.st[1];
        if (nloc == 0u) { xcd_barrier_complete(bar, b.x, nloc, nx); b.st[0] = nloc; b.st[1] = nx; }
        const unsigned old = xb_add(&bar[XB_XSUB(b.x)], 1u);
        const unsigned gen = old / nloc;
        if (old + 1u == (gen + 1u) * nloc) {
            __builtin_amdgcn_fence(__ATOMIC_RELEASE, "agent");
            asm volatile("s_waitcnt vmcnt(0)" ::: "memory");
            const unsigned og = xb_add(&bar[XB_TOP], 1u);
            const unsigned tg = og / nx;
            if (og + 1u == (tg + 1u) * nx) xb_add(&bar[XB_TOPGEN], 1u);
            else XB_SPIN(xb_ld(&bar[XB_TOPGEN]) == tg, bar);
            __builtin_amdgcn_fence(__ATOMIC_ACQUIRE, "agent");
            xb_add(&bar[XB_XGEN(b.x)], 1u);
            asm volatile("s_waitcnt vmcnt(0)" ::: "memory");
        } else {
            XB_SPIN(xb_ld(&bar[XB_XGEN(b.x)]) == gen, bar);
            __builtin_amdgcn_fence(__ATOMIC_ACQUIRE, "agent");
            asm volatile("s_waitcnt vmcnt(0)" ::: "memory");
        }
    }
    __syncthreads();
}


namespace att {
using bf16x8 = __attribute__((ext_vector_type(8))) short;
using s16x4  = __attribute__((ext_vector_type(4))) short;
using f32x16 = __attribute__((ext_vector_type(16))) float;
using u32x4  = __attribute__((ext_vector_type(4))) unsigned;
constexpr int D = 128, NW = 8, QBLK = 32, KVBLK = 64;
constexpr int LDQ = 3072, LDO = 2048;
constexpr float SCALE = 0.088388347648318440f;
constexpr float THR = 4.f;
constexpr size_t SHM_V = KVBLK * D * 2, SHM_K = KVBLK * D * 2, SHM_ATTN = 2 * SHM_V + 2 * SHM_K + NW * 64 * 4;
#define KSWZ(row, colB) ((row) * 256 + ((colB) ^ (((row) & 7) << 4)))
#define SBAR() __builtin_amdgcn_sched_barrier(0)
__device__ __forceinline__ int crow(int r, int hi) { return (r & 3) + 8 * (r >> 2) + 4 * hi; }
__device__ __forceinline__ unsigned cvtpk(float lo, float hi) { unsigned r; asm volatile("v_cvt_pk_bf16_f32 %0, %1, %2" : "=v"(r) : "v"(lo), "v"(hi)); return r; }

__device__ __forceinline__ void partialSM(f32x16& p0, f32x16& p1, float& m_reg, float& mn, float& alpha) {
  constexpr float C = SCALE * 1.4426950408889634f;
  float pmax = p0[0];
#pragma unroll
  for (int r = 1; r < 16; ++r) pmax = fmaxf(pmax, p0[r]);
#pragma unroll
  for (int r = 0; r < 16; ++r) pmax = fmaxf(pmax, p1[r]);
  { auto rr = __builtin_amdgcn_permlane32_swap(__float_as_uint(pmax), __float_as_uint(pmax), false, false);
    pmax = fmaxf(__uint_as_float(rr[0]), __uint_as_float(rr[1])); }
  if (__builtin_expect(__all(pmax - m_reg <= THR / SCALE), 1)) { mn = m_reg; alpha = 1.f; }
  else { mn = fmaxf(m_reg, pmax); alpha = __builtin_amdgcn_exp2f((m_reg - mn) * C); m_reg = mn; }
  float mnC = -mn * C;
#pragma unroll
  for (int r = 0; r < 16; ++r) p0[r] = fmaf(p0[r], C, mnC);
#pragma unroll
  for (int r = 0; r < 16; ++r) p1[r] = fmaf(p1[r], C, mnC);
#pragma unroll
  for (int r = 0; r < 16; ++r) p0[r] = __builtin_amdgcn_exp2f(p0[r]);
}
__device__ __forceinline__ void finishSM(f32x16& p0, f32x16& p1, float alpha, float& l_reg, bf16x8& pa0, bf16x8& pa1, bf16x8& pa2, bf16x8& pa3) {
#pragma unroll
  for (int r = 0; r < 16; ++r) p1[r] = __builtin_amdgcn_exp2f(p1[r]);
  float ps = 0;
#pragma unroll
  for (int r = 0; r < 16; ++r) ps += p0[r];
#pragma unroll
  for (int r = 0; r < 16; ++r) ps += p1[r];
  { auto rr = __builtin_amdgcn_permlane32_swap(__float_as_uint(ps), __float_as_uint(ps), false, false);
    ps = __uint_as_float(rr[0]) + __uint_as_float(rr[1]); }
  l_reg = l_reg * alpha + ps;
#define PK4(P, BASE, OUT) do { unsigned a0 = cvtpk(P[BASE + 0], P[BASE + 1]), a1 = cvtpk(P[BASE + 2], P[BASE + 3]);   \
    unsigned b0 = cvtpk(P[BASE + 4], P[BASE + 5]), b1 = cvtpk(P[BASE + 6], P[BASE + 7]);                              \
    auto r0 = __builtin_amdgcn_permlane32_swap(a0, b0, false, false); auto r1 = __builtin_amdgcn_permlane32_swap(a1, b1, false, false); \
    u32x4 w = {r0[0], r1[0], r0[1], r1[1]}; OUT = *reinterpret_cast<bf16x8*>(&w); } while (0)
  PK4(p0, 0, pa0); PK4(p0, 8, pa1); PK4(p1, 0, pa2); PK4(p1, 8, pa3);
#undef PK4
}
__device__ __forceinline__ void qkt(f32x16& p0, f32x16& p1, const char* Ks, const bf16x8* qr, int r32, int hi) {
  p0 = f32x16{}; p1 = f32x16{};
#pragma unroll
  for (int d0 = 0; d0 < 8; ++d0) { int cb = (d0 * 16 + hi * 8) * 2;
    bf16x8 b0 = *reinterpret_cast<const bf16x8*>(Ks + KSWZ(r32, cb));
    bf16x8 b1 = *reinterpret_cast<const bf16x8*>(Ks + KSWZ(32 + r32, cb));
    p0 = __builtin_amdgcn_mfma_f32_32x32x16_bf16(b0, qr[d0], p0, 0, 0, 0);
    p1 = __builtin_amdgcn_mfma_f32_32x32x16_bf16(b1, qr[d0], p1, 0, 0, 0); }
}
__device__ __forceinline__ void mask_tile(f32x16& p0, f32x16& p1, int dlt0, int hi) {
#pragma unroll
  for (int r = 0; r < 16; ++r) { const int d = dlt0 + crow(r, hi);
    if (d < -128 || d > 128) p0[r] = -1e30f;
    if (d + 32 < -128 || d + 32 > 128) p1[r] = -1e30f; }
}
__device__ __forceinline__ int v_st(int k, int c) { const int kk = (k & ~0xC) | ((k & 4) << 1) | ((k & 8) >> 1); return ((kk >> 3) * 4 + (c >> 5)) * 512 + ((kk & 7) * 32 + (c & 31)) * 2; }
__device__ __forceinline__ int v_rd_base(int lane) { return ((lane & 3) << 3) | (((lane >> 2) & 3) << 6) | (((lane >> 4) & 1) << 5) | (((lane >> 5) & 1) << 8); }
constexpr int v_rd_off(int d0, int ks, int half) { return d0 * 512 + ks * 4096 + half * 2048; }
template <int OFF> __device__ __forceinline__ s16x4 tr_read(int vb) {
  s16x4 r; asm volatile("ds_read_b64_tr_b16 %0, %1 offset:%2" : "=&v"(r) : "v"(vb), "i"(OFF) : "memory"); return r;
}
template <int D0> __device__ __forceinline__ void pv_one(f32x16& od, int vb, bf16x8 pa0, bf16x8 pa1, bf16x8 pa2, bf16x8 pa3) {
  const s16x4 l0 = tr_read<v_rd_off(D0, 0, 0)>(vb), h0 = tr_read<v_rd_off(D0, 0, 1)>(vb), l1 = tr_read<v_rd_off(D0, 1, 0)>(vb), h1 = tr_read<v_rd_off(D0, 1, 1)>(vb);
  const s16x4 l2 = tr_read<v_rd_off(D0, 2, 0)>(vb), h2 = tr_read<v_rd_off(D0, 2, 1)>(vb), l3 = tr_read<v_rd_off(D0, 3, 0)>(vb), h3 = tr_read<v_rd_off(D0, 3, 1)>(vb);
  asm volatile("s_waitcnt lgkmcnt(0)" ::: "memory"); SBAR();
#define PK(L, H) (bf16x8){L[0], L[1], L[2], L[3], H[0], H[1], H[2], H[3]}
  od = __builtin_amdgcn_mfma_f32_32x32x16_bf16(pa0, PK(l0, h0), od, 0, 0, 0);
  od = __builtin_amdgcn_mfma_f32_32x32x16_bf16(pa1, PK(l1, h1), od, 0, 0, 0);
  od = __builtin_amdgcn_mfma_f32_32x32x16_bf16(pa2, PK(l2, h2), od, 0, 0, 0);
  od = __builtin_amdgcn_mfma_f32_32x32x16_bf16(pa3, PK(l3, h3), od, 0, 0, 0);
#undef PK
}
__device__ __forceinline__ void pv_d0(f32x16* o, int vb, bf16x8 pa0, bf16x8 pa1, bf16x8 pa2, bf16x8 pa3) {
  pv_one<0>(o[0], vb, pa0, pa1, pa2, pa3); pv_one<1>(o[1], vb, pa0, pa1, pa2, pa3); pv_one<2>(o[2], vb, pa0, pa1, pa2, pa3); pv_one<3>(o[3], vb, pa0, pa1, pa2, pa3);
}

__device__ __forceinline__ void attn_unit(const unsigned short* __restrict__ QKV, unsigned short* __restrict__ Og, int qrow0, int qcol, int kcol, int vcol,
                                          int win_row0, int kpos_start, int nwin, int ctx_row0, int qpos0, float sink, char* lds) {
  int tid_o = threadIdx.x; asm volatile("" : "+v"(tid_o));
  const int tid = tid_o, wid = tid >> 6, lane = tid & 63, r32 = lane & 31, hi = lane >> 5;
  char* V_lds = lds; char* K_lds = lds + 2 * SHM_V;
  float* ws = (float*)(lds + 2 * SHM_V + 2 * SHM_K) + wid * 64; float* li_l = ws; float* al_l = ws + 32;
  float m_reg = sink * (1.0f / SCALE), l_reg = 1.f; f32x16 o[4] = {}; bf16x8 qr[8];
  const unsigned short* Qw = QKV + (size_t)(qrow0 + wid * QBLK + r32) * LDQ + qcol + hi * 8;
#pragma unroll
  for (int d0 = 0; d0 < 8; ++d0) qr[d0] = *reinterpret_cast<const bf16x8*>(Qw + d0 * 16);
  const int sr = tid >> 4, sc = (tid & 15) * 8, vst0 = v_st(sr, sc), vst1 = v_st(32 + sr, sc);
  const int vb0 = (int)(uintptr_t)V_lds + v_rd_base(lane);
  const int NT = nwin + 4;
  const int qpos = qpos0 + wid * QBLK + r32, qpmin = qpos0 + wid * QBLK;
  struct { bf16x8 vs0, vs1, ks0, ks1; } sr_[2];
#define TROW(j) ((j) < nwin ? win_row0 + 64 * (j) : ctx_row0 + 64 * ((j) - nwin))
#define SLOAD(i, j) do { const unsigned short* tb_ = QKV + (size_t)(TROW(j) + sr) * LDQ + sc; \
    sr_[i].vs0 = *reinterpret_cast<const bf16x8*>(tb_ + vcol); sr_[i].vs1 = *reinterpret_cast<const bf16x8*>(tb_ + (size_t)32 * LDQ + vcol); \
    sr_[i].ks0 = *reinterpret_cast<const bf16x8*>(tb_ + kcol); sr_[i].ks1 = *reinterpret_cast<const bf16x8*>(tb_ + (size_t)32 * LDQ + kcol); } while (0)
#define SWRITE(b, i) do { *(bf16x8*)(V_lds + (b) * SHM_V + vst0) = sr_[i].vs0; *(bf16x8*)(V_lds + (b) * SHM_V + vst1) = sr_[i].vs1; int kc = sc * 2; \
    *(bf16x8*)(K_lds + (b) * SHM_K + KSWZ(sr, kc)) = sr_[i].ks0; *(bf16x8*)(K_lds + (b) * SHM_K + KSWZ(32 + sr, kc)) = sr_[i].ks1; } while (0)
#define SWAIT() asm volatile("s_waitcnt vmcnt(4)" ::: "memory")
#define RESC(a) do { if (__any((a) < 1.f)) { if (hi == 0) al_l[r32] = (a); asm volatile("s_waitcnt lgkmcnt(0)" ::: "memory"); \
    _Pragma("unroll") for (int d = 0; d < 4; ++d) _Pragma("unroll") for (int r = 0; r < 16; ++r) o[d][r] *= al_l[crow(r, hi)]; } } while (0)
#define MASK(P0_, P1_, j) do { if ((j) < nwin) { const int kp0_ = kpos_start + 64 * (j); \
    if (!(kp0_ - (qpmin + 31) >= -128 && kp0_ + 63 - qpmin <= 128)) mask_tile(P0_, P1_, kp0_ - qpos, hi); } } while (0)
  f32x16 pA0, pA1, pB0, pB1; float mnA, mnB, alA, alB; bf16x8 pa0, pa1, pa2, pa3;
  constexpr int SE = 0, SO = 1;
  SLOAD(SE, 0); asm volatile("s_waitcnt vmcnt(0)" ::: "memory"); SWRITE(0, SE); __syncthreads();
  qkt(pA0, pA1, K_lds, qr, r32, hi); MASK(pA0, pA1, 0); partialSM(pA0, pA1, m_reg, mnA, alA);
  SLOAD(SO, 1); if (2 < NT) SLOAD(SE, 2);
  SWAIT(); SWRITE(1, SO); __syncthreads();
  for (int j = 1; j + 1 < NT; j += 2) {
    SBAR(); qkt(pB0, pB1, K_lds + SHM_K, qr, r32, hi);
    finishSM(pA0, pA1, alA, l_reg, pa0, pa1, pa2, pa3); SBAR();
    SLOAD(SO, j + 2); SBAR();
    pv_d0(o, vb0, pa0, pa1, pa2, pa3); MASK(pB0, pB1, j); partialSM(pB0, pB1, m_reg, mnB, alB);
    __syncthreads(); SWAIT(); SWRITE(0, SE);
    RESC(alB); __syncthreads();
    SBAR(); qkt(pA0, pA1, K_lds, qr, r32, hi);
    finishSM(pB0, pB1, alB, l_reg, pa0, pa1, pa2, pa3); SBAR();
    if (j + 3 < NT) SLOAD(SE, j + 3); SBAR();
    pv_d0(o, vb0 + (int)SHM_V, pa0, pa1, pa2, pa3); MASK(pA0, pA1, j + 1); partialSM(pA0, pA1, m_reg, mnA, alA);
    __syncthreads(); SWAIT(); SWRITE(1, SO);
    RESC(alA); __syncthreads();
  }
  SBAR(); qkt(pB0, pB1, K_lds + SHM_K, qr, r32, hi);
  finishSM(pA0, pA1, alA, l_reg, pa0, pa1, pa2, pa3); SBAR();
  pv_d0(o, vb0, pa0, pa1, pa2, pa3); MASK(pB0, pB1, NT - 1); partialSM(pB0, pB1, m_reg, mnB, alB);
  __syncthreads(); RESC(alB);
  finishSM(pB0, pB1, alB, l_reg, pa0, pa1, pa2, pa3); SBAR();
  pv_d0(o, vb0 + (int)SHM_V, pa0, pa1, pa2, pa3);
  if (hi == 0) li_l[r32] = l_reg; asm volatile("s_waitcnt lgkmcnt(0)" ::: "memory");
  float rli[16];
#pragma unroll
  for (int r = 0; r < 16; ++r) rli[r] = __builtin_amdgcn_rcpf(li_l[crow(r, hi)]);
  unsigned short* Ow = Og + (size_t)(qrow0 + wid * QBLK) * LDO + qcol;
#pragma unroll
  for (int r = 0; r < 16; ++r) { const int orow = crow(r, hi);
#pragma unroll
    for (int d0 = 0; d0 < 4; ++d0) { const unsigned w = cvtpk(o[d0][r] * rli[r], 0.f); Ow[(size_t)orow * LDO + d0 * 32 + r32] = (unsigned short)(w & 0xffffu); } }
#undef TROW
#undef SLOAD
#undef SWRITE
#undef SWAIT
#undef RESC
#undef MASK
}
#undef KSWZ
#undef SBAR
}


namespace scn {
using bf16x8 = __attribute__((ext_vector_type(8))) short;
using f32x4  = __attribute__((ext_vector_type(4))) float;
using f32x2  = __attribute__((ext_vector_type(2))) float;
using u32x4  = __attribute__((ext_vector_type(4))) unsigned;
using u32x2  = __attribute__((ext_vector_type(2))) unsigned;
constexpr int QK_STRIDE = 272, T_STRIDE = 144;
constexpr int QS = 0, KS = QS + 64 * QK_STRIDE, KT = KS + 64 * QK_STRIDE, VT = KT + 128 * T_STRIDE, ST = VT + 128 * T_STRIDE, PS = ST + 128 * QK_STRIDE,
              TT = PS + 64 * T_STRIDE, SC = TT + 8 * 128 * 4, DP = SC + 512, SCAN_LDS = DP + 512;
static_assert(SCAN_LDS <= 131072, "scan LDS");
__device__ __forceinline__ unsigned cvtpk(float lo, float hi) { unsigned r; asm volatile("v_cvt_pk_bf16_f32 %0, %1, %2" : "=v"(r) : "v"(lo), "v"(hi)); return r; }
__device__ __forceinline__ float bflo(unsigned w) { return __uint_as_float(w << 16); }
__device__ __forceinline__ float bfhi(unsigned w) { return __uint_as_float(w & 0xffff0000u); }

__device__ __forceinline__ int tok_row(int b, int dir, int ci, int tt) {
    if (ci < 4) { const int n = ci * 64 + tt; return 16384 + b * 256 + (dir ? 255 - n : n); }
    const int n = (ci - 4) * 64 + tt; return b * 2048 + (dir ? 2047 - n : n);
}

__device__ __forceinline__ void scan_seq(const unsigned short* __restrict__ RQ, const unsigned short* __restrict__ RV, const float* __restrict__ LFd, float* __restrict__ OUT,
                                         int b, int h, int dir, char* lds) {
    int tid_o = threadIdx.x; asm volatile("" : "+v"(tid_o));
    const int tid = tid_o, w = tid >> 6, lane = tid & 63, l15 = lane & 15, q4 = lane >> 4;
    const int k2 = lane;
    const int colb = h * 128 + 2 * k2;
    f32x4 acc[8];
#pragma unroll
    for (int i = 0; i < 8; ++i) acc[i] = (f32x4){0.f, 0.f, 0.f, 0.f};
    if (tid < 128) ((float*)(lds + DP))[tid] = 0.f;
    f32x2 lf[8]; unsigned qv[8], vv[8];
#define SC_LOAD(ci_) do { _Pragma("unroll") for (int i = 0; i < 8; ++i) { const size_t ro_ = (size_t)tok_row(b, dir, (ci_), 8 * w + i) * 2048 + colb; \
        lf[i] = *(const f32x2*)(LFd + ro_); qv[i] = *(const unsigned*)(RQ + ro_); vv[i] = *(const unsigned*)(RV + ro_); } } while (0)
    SC_LOAD(0);
    for (int ci = 0; ci < 36; ++ci) {
        float cA[8], cB[8]; float sA = 0.f, sB = 0.f;
#pragma unroll
        for (int i = 0; i < 8; ++i) { sA += lf[i].x; sB += lf[i].y; cA[i] = sA; cB[i] = sB; }
        *(f32x2*)(lds + TT + (w * 128 + 2 * k2) * 4) = (f32x2){sA, sB};
        __syncthreads();
        float offA = 0.f, offB = 0.f, totA = 0.f, totB = 0.f;
#pragma unroll
        for (int s = 0; s < 8; ++s) { const f32x2 t = *(const f32x2*)(lds + TT + (s * 128 + 2 * k2) * 4);
            if (s < w) { offA += t.x; offB += t.y; } totA += t.x; totB += t.y; }
const float rA = 0.f, rB = 0.f;
        unsigned qt[8], kt[8]; unsigned ktA[4], ktB[4], vtA[4], vtB[4];
        float kprevA = 0.f, kprevB = 0.f;
#pragma unroll
        for (int i = 0; i < 8; ++i) {
            const float dA = fminf(fmaxf(offA + cA[i] - rA, -80.f), 80.f), dB = fminf(fmaxf(offB + cB[i] - rB, -80.f), 80.f);
            const float eA = __expf(dA), eB = __expf(dB), ieA = __expf(-dA), ieB = __expf(-dB);
            const float kkA = 1.0f - __expf(lf[i].x), kkB = 1.0f - __expf(lf[i].y);
            const float qA = bflo(qv[i]) * eA, qB = bfhi(qv[i]) * eB, kA = kkA * ieA, kB = kkB * ieB;
            qt[i] = cvtpk(qA, qB); kt[i] = cvtpk(kA, kB);
            if (i & 1) { ktA[i >> 1] = cvtpk(kprevA, kA); ktB[i >> 1] = cvtpk(kprevB, kB);
                         vtA[i >> 1] = (vv[i - 1] & 0xffffu) | (vv[i] << 16); vtB[i >> 1] = (vv[i - 1] >> 16) | (vv[i] & 0xffff0000u); }
            kprevA = kA; kprevB = kB;
        }
#pragma unroll
        for (int i = 0; i < 8; ++i) { *(unsigned*)(lds + QS + (8 * w + i) * QK_STRIDE + 4 * k2) = qt[i]; *(unsigned*)(lds + KS + (8 * w + i) * QK_STRIDE + 4 * k2) = kt[i]; }
        *(u32x4*)(lds + KT + (2 * k2) * T_STRIDE + 16 * w) = (u32x4){ktA[0], ktA[1], ktA[2], ktA[3]};
        *(u32x4*)(lds + KT + (2 * k2 + 1) * T_STRIDE + 16 * w) = (u32x4){ktB[0], ktB[1], ktB[2], ktB[3]};
        *(u32x4*)(lds + VT + (2 * k2) * T_STRIDE + 16 * w) = (u32x4){vtA[0], vtA[1], vtA[2], vtA[3]};
        *(u32x4*)(lds + VT + (2 * k2 + 1) * T_STRIDE + 16 * w) = (u32x4){vtB[0], vtB[1], vtB[2], vtB[3]};
        if (w == 0) { f32x2* dp = (f32x2*)(lds + DP + 8 * k2); const f32x2 d = *dp;
            *(f32x2*)(lds + SC + 8 * k2) = (f32x2){__expf(fmaxf(d.x + rA, -80.f)), __expf(fmaxf(d.y + rB, -80.f))};
            *dp = (f32x2){totA - rA, totB - rB}; }
        if (ci + 1 < 36) SC_LOAD(ci + 1);
        __syncthreads();
        { const f32x4 s4 = *(const f32x4*)(lds + SC + (16 * w + 4 * q4) * 4);
#pragma unroll
          for (int vb = 0; vb < 8; ++vb) { acc[vb] = acc[vb] * s4;
              *(u32x2*)(lds + ST + (16 * vb + l15) * QK_STRIDE + (16 * w + 4 * q4) * 2) = (u32x2){cvtpk(acc[vb][0], acc[vb][1]), cvtpk(acc[vb][2], acc[vb][3])}; } }
        { const int sb = w >> 1;
#pragma unroll
          for (int e = 0; e < 2; ++e) { const int tb = 2 * (w & 1) + e; f32x4 p = (f32x4){0.f, 0.f, 0.f, 0.f};
              if (sb <= tb) {
#pragma unroll
                  for (int ks = 0; ks < 4; ++ks) { const bf16x8 a = *(const bf16x8*)(lds + KS + (16 * sb + l15) * QK_STRIDE + 64 * ks + 16 * q4);
                      const bf16x8 bq = *(const bf16x8*)(lds + QS + (16 * tb + l15) * QK_STRIDE + 64 * ks + 16 * q4);
                      p = __builtin_amdgcn_mfma_f32_16x16x32_bf16(a, bq, p, 0, 0, 0); }
                  const int t = 16 * tb + l15, s0 = 16 * sb + 4 * q4;
#pragma unroll
                  for (int r = 0; r < 4; ++r) p[r] = (s0 + r <= t) ? p[r] : 0.f;
              }
              *(u32x2*)(lds + PS + (16 * tb + l15) * T_STRIDE + (16 * sb + 4 * q4) * 2) = (u32x2){cvtpk(p[0], p[1]), cvtpk(p[2], p[3])}; } }
#pragma unroll
        for (int ks = 0; ks < 2; ++ks) { const bf16x8 a = *(const bf16x8*)(lds + KT + (16 * w + l15) * T_STRIDE + 64 * ks + 16 * q4);
#pragma unroll
            for (int vb = 0; vb < 8; ++vb) { const bf16x8 bv = *(const bf16x8*)(lds + VT + (16 * vb + l15) * T_STRIDE + 64 * ks + 16 * q4);
                acc[vb] = __builtin_amdgcn_mfma_f32_16x16x32_bf16(a, bv, acc[vb], 0, 0, 0); } }
        __syncthreads();
        { const int tb = w & 3, vg = w >> 2; f32x4 o[4];
#pragma unroll
          for (int e = 0; e < 4; ++e) o[e] = (f32x4){0.f, 0.f, 0.f, 0.f};
#pragma unroll
          for (int ks = 0; ks < 4; ++ks) { const bf16x8 a = *(const bf16x8*)(lds + QS + (16 * tb + l15) * QK_STRIDE + 64 * ks + 16 * q4);
#pragma unroll
              for (int e = 0; e < 4; ++e) { const bf16x8 bs = *(const bf16x8*)(lds + ST + (16 * (4 * vg + e) + l15) * QK_STRIDE + 64 * ks + 16 * q4);
                  o[e] = __builtin_amdgcn_mfma_f32_16x16x32_bf16(a, bs, o[e], 0, 0, 0); } }
#pragma unroll
          for (int ks = 0; ks < 2; ++ks) { const bf16x8 a = *(const bf16x8*)(lds + PS + (16 * tb + l15) * T_STRIDE + 64 * ks + 16 * q4);
#pragma unroll
              for (int e = 0; e < 4; ++e) { const bf16x8 bv = *(const bf16x8*)(lds + VT + (16 * (4 * vg + e) + l15) * T_STRIDE + 64 * ks + 16 * q4);
                  o[e] = __builtin_amdgcn_mfma_f32_16x16x32_bf16(a, bv, o[e], 0, 0, 0); } }
#if defined(DBG_SKIP_CTX_STORE)
          if (ci >= 4)
#endif
#pragma unroll
          for (int r = 0; r < 4; ++r) { float* orow = OUT + (size_t)tok_row(b, dir, ci, 16 * tb + 4 * q4 + r) * 2048 + h * 128 + 16 * (4 * vg) + l15;
#pragma unroll
              for (int e = 0; e < 4; ++e) orow[16 * e] = o[e][r]; } }
        __syncthreads();
    }
#undef SC_LOAD
}
}


namespace dbg {
__device__ __forceinline__ float bf2f(unsigned short v) { return __uint_as_float(((unsigned)v) << 16); }
__device__ __forceinline__ unsigned short f2bf16(float f) { unsigned u = __float_as_uint(f); return (unsigned short)((u + 0x7fffu + ((u >> 16) & 1u)) >> 16); }
__device__ __forceinline__ void slow_attn(const unsigned short* QKV, unsigned short* O, const float* sink, char* lds, int lane, int wave, int gw, int NGW) {
    float* qs = (float*)(lds + wave * 4096); float* sc = qs + 128;
    for (int item = gw; item < 18432 * 16; item += NGW) {
        const int row = item >> 4, h = item & 15, hk = h >> 2;
        const bool lat = row < 16384; const int b = lat ? (row >> 11) : ((row - 16384) >> 8); const int t = row & 2047;
        const int lo = lat ? (t - 128 < 0 ? 0 : t - 128) : 0, hi = lat ? (t + 128 > 2047 ? 2047 : t + 128) : -1, nw = hi - lo + 1, total = nw + 256;
        const unsigned short* qp = QKV + (size_t)row * 3072 + h * 128;
        qs[lane] = bf2f(qp[lane]); qs[64 + lane] = bf2f(qp[64 + lane]);
        asm volatile("s_waitcnt lgkmcnt(0)" ::: "memory");
        float mx = sink[h];
        for (int kk = lane; kk < total; kk += 64) {
            const int krow = kk < nw ? b * 2048 + lo + kk : 16384 + b * 256 + (kk - nw);
            const unsigned short* kp = QKV + (size_t)krow * 3072 + 2048 + hk * 128; float d = 0.f;
            for (int e = 0; e < 128; ++e) d += qs[e] * bf2f(kp[e]);
            d *= 0.088388347648318440f; sc[kk] = d; mx = fmaxf(mx, d);
        }
        for (int o = 1; o < 64; o <<= 1) mx = fmaxf(mx, __shfl_xor(mx, o));
        float sum = 0.f;
        for (int kk = lane; kk < total; kk += 64) { const float p = __expf(sc[kk] - mx); sc[kk] = p; sum += p; }
        for (int o = 1; o < 64; o <<= 1) sum += __shfl_xor(sum, o);
        sum += __expf(sink[h] - mx);
        asm volatile("s_waitcnt lgkmcnt(0)" ::: "memory");
        float o0 = 0.f, o1 = 0.f;
        for (int kk = 0; kk < total; ++kk) { const int krow = kk < nw ? b * 2048 + lo + kk : 16384 + b * 256 + (kk - nw);
            const unsigned vv = *(const unsigned*)(QKV + (size_t)krow * 3072 + 2560 + hk * 128 + 2 * lane); const float p = sc[kk];
            o0 += p * __uint_as_float(vv << 16); o1 += p * __uint_as_float(vv & 0xffff0000u); }
        const float inv = 1.0f / sum;
        *(unsigned*)(O + (size_t)row * 2048 + h * 128 + 2 * lane) = (unsigned)f2bf16(o0 * inv) | ((unsigned)f2bf16(o1 * inv) << 16);
        asm volatile("s_waitcnt lgkmcnt(0)" ::: "memory");
    }
}
__device__ __forceinline__ void slow_scan(const unsigned short* RQ, const unsigned short* RV, const float* LFd, float* OUT, int b, int h, int dir, char* lds, int tid) {
    float* fL = (float*)lds; float* kL = fL + 128; float* qL = kL + 128; float* vL = qL + 128; float* part = vL + 128;
    const int v = tid & 127, kq = tid >> 7;
    float S[32];
#pragma unroll
    for (int i = 0; i < 32; ++i) S[i] = 0.f;
    for (int n = 0; n < 2304; ++n) {
        const int row = n < 256 ? 16384 + b * 256 + (dir ? 255 - n : n) : b * 2048 + (dir ? 2047 - (n - 256) : (n - 256));
        if (tid < 128) { const float lf = LFd[(size_t)row * 2048 + h * 128 + tid]; const float f = __expf(lf); fL[tid] = f; kL[tid] = 1.0f - f;
            qL[tid] = bf2f(RQ[(size_t)row * 2048 + h * 128 + tid]); vL[tid] = bf2f(RV[(size_t)row * 2048 + h * 128 + tid]); }
        __syncthreads();
        const float vv = vL[v]; float o = 0.f;
#pragma unroll
        for (int i = 0; i < 32; ++i) { const int k = kq * 32 + i; S[i] = fL[k] * S[i] + kL[k] * vv; o += S[i] * qL[k]; }
        part[kq * 128 + v] = o;
        __syncthreads();
        if (tid < 128) OUT[(size_t)row * 2048 + h * 128 + tid] = (part[tid] + part[128 + tid]) + (part[256 + tid] + part[384 + tid]);
        __syncthreads();
    }
}
}


constexpr int NWAVES = 8;
constexpr int DM = 2048, NBATCH = 8, SEQ = 2048, CTXL = 256, DEPTH = 4;
constexpr int ML = NBATCH * SEQ, MC = NBATCH * CTXL, MT = ML + MC;
constexpr int NQKV = 3072, NREC = 10240, DFF = 8192, NMOD = 12288;
constexpr float NORM_EPS = 1e-6f;
constexpr int N_PHASES = 3 + 8 * DEPTH;

constexpr size_t MiB = 1u << 20;
constexpr size_t WS_CTL = 0, CTL_ZERO_BYTES = 1 * MiB;
constexpr size_t WS_MOD = 1 * MiB;
constexpr size_t WS_TAB = 4 * MiB;
constexpr size_t TAB_COS = 0, TAB_SIN = 8192, TAB_LB = 16384;
constexpr size_t WS_WQKV = 8 * MiB, WS_WAO = 32 * MiB, WS_WRI = 48 * MiB, WS_WRO = 128 * MiB, WS_WUP = 144 * MiB, WS_WDN = 272 * MiB;
constexpr size_t WS_X = 400 * MiB;
constexpr size_t WS_H = 544 * MiB;
constexpr size_t WS_O = 616 * MiB;
constexpr size_t WS_U = 688 * MiB;
constexpr size_t WS_OF = WS_U, WS_OB = WS_U + 144 * MiB;
constexpr size_t WS_MIX = 976 * MiB;
constexpr size_t WS_RQ = WS_MIX, WS_RV = WS_MIX + 72 * MiB, WS_RG = WS_MIX + 144 * MiB, WS_LF = WS_MIX + 216 * MiB;
constexpr size_t WS_END = WS_MIX + 504 * MiB;
constexpr int CW_TMO = 0, CW_BAR = 4096;

constexpr int RING_BYTES = 131072, LDSCTL_OFF = RING_BYTES, MISC_OFF = LDSCTL_OFF + 320, LDS_BYTES = 147456;

__device__ __forceinline__ float wave_sum(float v) {
#pragma unroll
    for (int o = 1; o < 64; o <<= 1) v += __shfl_xor(v, o);
    return v;
}

__device__ __forceinline__ int rope_row(int n) {
    if (n >= 2560) return n;
    const int d = n & 127, a = d >> 6, jj = (d >> 5) & 1, i = d & 31;
    return (n & ~127) + a * 64 + (i >> 2) * 8 + jj * 4 + (i & 3);
}
__device__ __forceinline__ void transpose_item(const float* W, int K, int N, bf16* WT, bool perm, LAS float* scr, int item, int lane) {
    const int nblk = N / 32, kb = item / nblk, nb = item % nblk, k0 = 64 * kb, n0 = 32 * nb;
    const float* src = W + (size_t)(k0 + (lane >> 5)) * N + n0 + (lane & 31);
    float v[32];
#pragma unroll
    for (int i = 0; i < 32; ++i) v[i] = src[(size_t)(2 * i) * N];
#pragma unroll
    for (int i = 0; i < 32; ++i) scr[(2 * i + (lane >> 5)) * 33 + (lane & 31)] = v[i];
    LDS_WAIT(); asm volatile("" ::: "memory");
    const int c = lane & 7;
#pragma unroll
    for (int j = 0; j < 4; ++j) { const int n = (lane >> 3) + 8 * j; const LAS float* s = scr + (8 * c) * 33 + n;
        v4u o; o.x = pk2(s[0 * 33], s[1 * 33]); o.y = pk2(s[2 * 33], s[3 * 33]); o.z = pk2(s[4 * 33], s[5 * 33]); o.w = pk2(s[6 * 33], s[7 * 33]);
        const int row = perm ? rope_row(n0 + n) : (n0 + n);
        *(GAS v4u*)(WT + (size_t)row * K + k0 + 8 * c) = o; }
    LDS_WAIT(); asm volatile("" ::: "memory");
}

struct KArgs { const float* in[18]; float* out; unsigned char* ws; int ph_lo, ph_hi; };

__device__ __forceinline__ unsigned long long ld_u64(volatile LAS unsigned* PT, int idx);
__device__ __forceinline__ void p0_prologue(volatile LAS unsigned* PT, LAS unsigned char* lds, int tid, int lane, int wave, int gw, int NGW) {
    unsigned char* ws = (unsigned char*)(GAS unsigned char*)ld_u64(PT, 19);
    LAS float* sc = (LAS float*)lds;
    for (int i = tid; i < 9 * DM; i += NWAVES * 64) { const float x = i < 8 * DM ? ((const float*)(const GAS float*)ld_u64(PT, 1))[i] : ((const float*)(const GAS float*)ld_u64(PT, 3))[i - 8 * DM]; sc[i] = x / (1.0f + __expf(-x)); }
    __syncthreads();
    { float* PART = (float*)(ws + WS_U);
      for (int tk = gw; tk < DEPTH * 48 * 16; tk += NGW) {
          const int i = tk / 768, rem = tk % 768, cg = rem >> 4, ks = rem & 15, col = cg * 256 + 4 * lane;
          const float* W = ((const float*)(const GAS float*)ld_u64(PT, 4)) + (size_t)i * DM * NMOD + (size_t)(ks * 128) * NMOD + col;
          f32x4 acc[9];
#pragma unroll
          for (int r = 0; r < 9; ++r) acc[r] = (f32x4){0.f, 0.f, 0.f, 0.f};
#pragma unroll 2
          for (int k4 = 0; k4 < 32; ++k4) {
              const f32x4 w0 = *(const f32x4*)(W + (size_t)(4 * k4 + 0) * NMOD), w1 = *(const f32x4*)(W + (size_t)(4 * k4 + 1) * NMOD),
                          w2 = *(const f32x4*)(W + (size_t)(4 * k4 + 2) * NMOD), w3 = *(const f32x4*)(W + (size_t)(4 * k4 + 3) * NMOD);
#pragma unroll
              for (int r = 0; r < 9; ++r) { const f32x4 s4 = *(const LAS f32x4*)(sc + r * DM + ks * 128 + 4 * k4);
                  acc[r] = acc[r] + w0 * s4.x + w1 * s4.y + w2 * s4.z + w3 * s4.w; }
          }
#pragma unroll
          for (int r = 0; r < 9; ++r) *(f32x4*)(PART + (((size_t)ks * DEPTH + i) * 9 + r) * NMOD + col) = acc[r];
      } }
    if (blockIdx.x == 0) {
        float* cosT = (float*)(ws + WS_TAB + TAB_COS); float* sinT = (float*)(ws + WS_TAB + TAB_SIN); float* LB = (float*)(ws + WS_TAB + TAB_LB);
        for (int i = tid; i < 64 * 32; i += NWAVES * 64) { const int pos = i >> 5, f = i & 31; const float inv = powf(10000.0f, -(float)f / 32.0f); const float ang = (float)pos * inv;
            float sv, cv; sincosf(ang, &sv, &cv); cosT[i] = cv; sinT[i] = sv; }
        for (int i = tid; i < 2 * DM; i += NWAVES * 64) { const float l0 = ((const float*)(const GAS float*)ld_u64(PT, 13))[i], l1 = ((const float*)(const GAS float*)ld_u64(PT, 13))[2 * DM + i]; const float mx = fmaxf(l0, l1);
            const float e0 = expf(l0 - mx), e1 = expf(l1 - mx), g0 = e0 / (e0 + e1), g1 = e1 / (e0 + e1);
            LB[i] = g0 - g0; LB[2 * DM + i] = (g0 + g1) - g0; }
    }
    __syncthreads();
    LAS float* scr = (LAS float*)(lds + wave * 8448);
    constexpr int I_QKV = (DM / 64) * (NQKV / 32), I_WO = (DM / 64) * (DM / 32), I_RI = (DM / 64) * (NREC / 32), I_UP = (DM / 64) * (DFF / 32), I_DN = (DFF / 64) * (DM / 32);
    constexpr int T0 = 2 * I_QKV, T1 = T0 + 2 * I_WO, T2 = T1 + 2 * I_RI, T3 = T2 + 2 * I_WO, T4 = T3 + 4 * I_UP, T5 = T4 + 4 * I_DN;
    for (int it = gw; it < T5; it += NGW) {
        if (it < T0) { const int l = it / I_QKV, r = it % I_QKV; transpose_item(((const float*)(const GAS float*)ld_u64(PT, 8)) + (size_t)l * DM * NQKV, DM, NQKV, (bf16*)(ws + WS_WQKV) + (size_t)l * NQKV * DM, true, scr, r, lane); }
        else if (it < T1) { const int q = it - T0, l = q / I_WO, r = q % I_WO; transpose_item(((const float*)(const GAS float*)ld_u64(PT, 9)) + (size_t)l * DM * DM, DM, DM, (bf16*)(ws + WS_WAO) + (size_t)l * DM * DM, false, scr, r, lane); }
        else if (it < T2) { const int q = it - T1, l = q / I_RI, r = q % I_RI; transpose_item(((const float*)(const GAS float*)ld_u64(PT, 11)) + (size_t)l * DM * NREC, DM, NREC, (bf16*)(ws + WS_WRI) + (size_t)l * NREC * DM, false, scr, r, lane); }
        else if (it < T3) { const int q = it - T2, l = q / I_WO, r = q % I_WO; transpose_item(((const float*)(const GAS float*)ld_u64(PT, 12)) + (size_t)l * DM * DM, DM, DM, (bf16*)(ws + WS_WRO) + (size_t)l * DM * DM, false, scr, r, lane); }
        else if (it < T4) { const int q = it - T3, l = q / I_UP, r = q % I_UP; transpose_item(((const float*)(const GAS float*)ld_u64(PT, 15)) + (size_t)l * DM * DFF, DM, DFF, (bf16*)(ws + WS_WUP) + (size_t)l * DFF * DM, false, scr, r, lane); }
        else { const int q = it - T4, l = q / I_DN, r = q % I_DN; transpose_item(((const float*)(const GAS float*)ld_u64(PT, 16)) + (size_t)l * DFF * DM, DFF, DM, (bf16*)(ws + WS_WDN) + (size_t)l * DM * DFF, false, scr, r, lane); }
    }
}


__device__ __forceinline__ void mod_reduce_phase(const float* PART, const float* bias, float* MOD, int tid, int bx, int G) {
    constexpr int TOT4 = DEPTH * 9 * NMOD / 4;
    for (int e = bx * (NWAVES * 64) + tid; e < TOT4; e += G * NWAVES * 64) {
        const int i = e / (9 * NMOD / 4), n4 = e % (NMOD / 4);
        f32x4 s = *(const f32x4*)(bias + (size_t)i * NMOD + 4 * n4);
#pragma unroll
        for (int ks = 0; ks < 16; ++ks) s = s + *(const GAS f32x4*)(PART + (size_t)ks * (DEPTH * 9 * NMOD) + 4 * (size_t)e);
        *(GAS f32x4*)(MOD + 4 * (size_t)e) = s;
    }
}
__device__ __forceinline__ void norm_phase(const float* xl, const float* xc, bf16* H, const float* g, const float* mod_i, int shift_chunk, int nrows, int lane, int gw, int NGW) {
    for (int r = gw; r < nrows; r += NGW) {
        const float* xr = r < ML ? xl + (size_t)r * DM : xc + (size_t)(r - ML) * DM;
        const int r9 = r < ML ? (r >> 11) : 8;
        const float* sh = mod_i + (size_t)r9 * NMOD + shift_chunk * DM; const float* scl = sh + DM;
        f32x4 v[8]; float ss = 0.f;
#pragma unroll
        for (int j = 0; j < 8; ++j) { v[j] = *(const GAS f32x4*)(xr + 4 * (lane + 64 * j)); ss += (v[j].x * v[j].x + v[j].y * v[j].y) + (v[j].z * v[j].z + v[j].w * v[j].w); }
        const float rstd = rsqrtf(wave_sum(ss) * (1.0f / DM) + NORM_EPS);
#pragma unroll
        for (int j = 0; j < 8; ++j) { const int c = 4 * (lane + 64 * j);
            const f32x4 gg = *(const f32x4*)(g + c), s1 = *(const f32x4*)(scl + c), s0 = *(const f32x4*)(sh + c);
            const f32x4 y = ((v[j] * rstd) * gg) * (s1 + 1.0f) + s0;
            *(GAS unsigned long long*)(H + (size_t)r * DM + c) = (unsigned long long)pk2(y.x, y.y) | ((unsigned long long)pk2(y.z, y.w) << 32); }
    }
}
__device__ __forceinline__ void readout_phase(const float* OF, const float* OB, const bf16* RG, const float* og, bf16* O, int nrows, int lane, int gw, int NGW) {
    const f32x4 g4 = *(const f32x4*)(og + ((4 * lane) & 127));
    for (int r = gw; r < nrows; r += NGW) {
#pragma unroll
        for (int j = 0; j < 8; ++j) { const size_t off = (size_t)r * DM + 4 * (lane + 64 * j);
            const f32x4 s = *(const GAS f32x4*)(OF + off) + *(const GAS f32x4*)(OB + off);
            const unsigned long long gw8 = *(const GAS unsigned long long*)(RG + off);
            float ss = (s.x * s.x + s.y * s.y) + (s.z * s.z + s.w * s.w);
#pragma unroll
            for (int o = 1; o < 32; o <<= 1) ss += __shfl_xor(ss, o);
            const float rstd = rsqrtf(ss * (1.0f / 128.0f) + NORM_EPS);
            const unsigned glo = (unsigned)gw8, ghi = (unsigned)(gw8 >> 32);
            const float y0 = (s.x * rstd) * g4.x * __uint_as_float(glo << 16), y1 = (s.y * rstd) * g4.y * __uint_as_float(glo & 0xffff0000u);
            const float y2 = (s.z * rstd) * g4.z * __uint_as_float(ghi << 16), y3 = (s.w * rstd) * g4.w * __uint_as_float(ghi & 0xffff0000u);
            *(GAS unsigned long long*)(O + off) = (unsigned long long)pk2(y0, y1) | ((unsigned long long)pk2(y2, y3) << 32); }
    }
}

__device__ __forceinline__ void final_norm_phase(const float* X, const float* g, float* out, int lane, int gw, int NGW) {
    for (int r = gw; r < ML; r += NGW) {
        f32x4 v[8]; float ss = 0.f;
#pragma unroll
        for (int j = 0; j < 8; ++j) { v[j] = *(const GAS f32x4*)(X + (size_t)r * DM + 4 * (lane + 64 * j)); ss += (v[j].x * v[j].x + v[j].y * v[j].y) + (v[j].z * v[j].z + v[j].w * v[j].w); }
        const float rstd = rsqrtf(wave_sum(ss) * (1.0f / DM) + NORM_EPS);
#pragma unroll
        for (int j = 0; j < 8; ++j) { const int c = 4 * (lane + 64 * j); *(GAS f32x4*)(out + (size_t)r * DM + c) = (v[j] * rstd) * *(const f32x4*)(g + c); }
    }
}

__device__ __forceinline__ unsigned long long ld_u64(volatile LAS unsigned* PT, int idx) {
    const unsigned lo = __builtin_amdgcn_readfirstlane(PT[2 * idx]), hi = __builtin_amdgcn_readfirstlane(PT[2 * idx + 1]);
    return ((unsigned long long)hi << 32) | lo;
}
#define PIN(i) ((const float*)(const GAS float*)ld_u64(PT, (i)))
#define PWS() ((unsigned char*)(GAS unsigned char*)ld_u64(PT, 19))
__global__ void __launch_bounds__(NWAVES * 64, 2) mk_fwd(KArgs args) {
    extern __shared__ __attribute__((aligned(16))) unsigned char lds[];
    LAS unsigned char* L = (LAS unsigned char*)lds;
    volatile LAS unsigned* MISC = (volatile LAS unsigned*)(L + MISC_OFF);
    volatile LAS unsigned* PT = (volatile LAS unsigned*)(L + MISC_OFF + 256);
    const int tid = threadIdx.x;
    for (int u = tid; u < (LDS_BYTES - LDSCTL_OFF) / 4; u += NWAVES * 64) ((LAS unsigned*)(L + LDSCTL_OFF))[u] = 0u;
    __syncthreads();
    if (tid == 0) {
#define PUT(i, p) do { const unsigned long long v_ = (unsigned long long)(p); PT[2 * (i)] = (unsigned)v_; PT[2 * (i) + 1] = (unsigned)(v_ >> 32); } while (0)
        PUT(0, args.in[0]); PUT(1, args.in[1]); PUT(2, args.in[2]); PUT(3, args.in[3]); PUT(4, args.in[4]); PUT(5, args.in[5]); PUT(6, args.in[6]); PUT(7, args.in[7]); PUT(8, args.in[8]);
        PUT(9, args.in[9]); PUT(10, args.in[10]); PUT(11, args.in[11]); PUT(12, args.in[12]); PUT(13, args.in[13]); PUT(14, args.in[14]); PUT(15, args.in[15]); PUT(16, args.in[16]);
        PUT(17, args.in[17]); PUT(18, args.out); PUT(19, args.ws); PT[40] = (unsigned)args.ph_lo; PT[41] = (unsigned)args.ph_hi;
#undef PUT
    }
    __syncthreads();
#define PH_LO() ((int)__builtin_amdgcn_readfirstlane(PT[40]))
#define PH_HI() ((int)__builtin_amdgcn_readfirstlane(PT[41]))
    if (PH_HI() - PH_LO() > 1) (void)xcd_barrier_post((unsigned*)((gu32*)(PWS() + WS_CTL) + CW_BAR), MISC + 8);
#define IN(k) (PH_LO() <= (k) && (k) < PH_HI())
#define SEAM(k) do { if ((k) + 1 < PH_HI()) { XcdBarrier b_; b_.bar = (unsigned*)((gu32*)(PWS() + WS_CTL) + CW_BAR); b_.x = xb_xcc_id(); b_.st = MISC + 8; xcd_barrier(b_); } } while (0)
#define GEO() int tid_g = threadIdx.x; asm volatile("" : "+v"(tid_g)); const int lane = tid_g & 63, wave = __builtin_amdgcn_readfirstlane(tid_g >> 6), G = gridDim.x, bx = blockIdx.x, \
                        vcu = (G % 8 == 0) ? (bx % 8) * (G / 8) + bx / 8 : bx, gw = vcu * NWAVES + wave, NGW = G * NWAVES; (void)lane; (void)gw; (void)NGW

    if (IN(0)) { GEO(); p0_prologue(PT, L, tid_g, lane, wave, gw, NGW); SEAM(0); }
    if (IN(1)) { GEO(); unsigned char* ws = PWS(); mod_reduce_phase((const float*)(ws + WS_U), PIN(5), (float*)(ws + WS_MOD), tid_g, bx, G); SEAM(1); }
    if (IN(2)) { GEO(); unsigned char* ws = PWS(); norm_phase(PIN(0), PIN(2), (bf16*)(ws + WS_H), PIN(6), (const float*)(ws + WS_MOD), 0, MT, lane, gw, NGW); SEAM(2); }

    for (int Lr = 0; Lr < DEPTH; ++Lr) {
        const int pb = 3 + 8 * Lr;
        if ((Lr & 1) == 0) {
            if (IN(pb + 0)) {
                GEO(); unsigned char* ws = PWS(); const int jl = Lr >> 1;
                pg8::Gemm g{(const bf16*)(ws + WS_H), (const bf16*)(ws + WS_WQKV) + (size_t)jl * NQKV * DM, MT, NQKV, DM}; pg8::StaticOrder S; S.init(MT, NQKV, G, bx);
                pg8::EpiQkv E{(bf16*)(ws + WS_MIX), (const float*)(ws + WS_TAB + TAB_COS), (const float*)(ws + WS_TAB + TAB_SIN)};
                pg8::gemm_phase<pg8::EpiQkv, pg8::StaticOrder, true, true>(L, g, S, E);
                SEAM(pb + 0);
            }
            if (IN(pb + 1)) {
                GEO(); unsigned char* ws = PWS(); const int jl = Lr >> 1;
                const bf16* QKV = (const bf16*)(ws + WS_MIX); bf16* Ob = (bf16*)(ws + WS_O); const float* sinkp = PIN(10) + jl * 16;
#if defined(DBG_SLOW_ATT)
                dbg::slow_attn(QKV, Ob, sinkp, (char*)lds, lane, wave, gw, NGW);
#else
                for (int u = bx; u < 1024 + 128; u += G) {
                    if (u < 1024) { const int gq = u & 3, qb = (u >> 2) & 7, hk = (u >> 5) & 3, b = u >> 7, h = hk * 4 + gq;
                        const int P0 = qb * 256, k0 = (P0 - 128 < 0) ? 0 : P0 - 128, k1 = (P0 + 384 > SEQ) ? SEQ : P0 + 384, nwin = (k1 - k0) >> 6;
                        att::attn_unit(QKV, Ob, b * SEQ + P0, h * 128, 2048 + hk * 128, 2560 + hk * 128, b * SEQ + k0, k0, nwin, ML + b * CTXL, P0, sinkp[h], (char*)lds);
                    } else { const int uc = u - 1024, h = uc & 15, b = uc >> 4, hk = h >> 2;
                        att::attn_unit(QKV, Ob, ML + b * CTXL, h * 128, 2048 + hk * 128, 2560 + hk * 128, 0, 0, 0, ML + b * CTXL, 0, sinkp[h], (char*)lds); }
                    __syncthreads();
                }
#endif
                SEAM(pb + 1);
            }
        } else {
            if (IN(pb + 0)) {
                GEO(); unsigned char* ws = PWS(); const int jl = Lr >> 1;
                pg8::Gemm g{(const bf16*)(ws + WS_H), (const bf16*)(ws + WS_WRI) + (size_t)jl * NREC * DM, MT, NREC, DM}; pg8::StaticOrder S; S.init(MT, NREC, G, bx);
                pg8::EpiRec E{(bf16*)(ws + WS_RQ), (bf16*)(ws + WS_RV), (bf16*)(ws + WS_RG), (float*)(ws + WS_LF), (const float*)(ws + WS_TAB + TAB_LB) + jl * 2 * DM, (size_t)MT * DM};
                pg8::gemm_phase<pg8::EpiRec, pg8::StaticOrder, true, true>(L, g, S, E);
                SEAM(pb + 0);
            }
            if (IN(pb + 1)) {
                GEO(); unsigned char* ws = PWS();
                for (int sid = bx; sid < 256; sid += G) { const int b = sid >> 5, h = (sid >> 1) & 15, dir = sid & 1;
#if defined(DBG_SLOW_SCAN)
                    if (DBG_SLOW_SCAN == 5) { dbg::slow_scan((const bf16*)(ws + WS_RQ), (const bf16*)(ws + WS_RV), (const float*)(ws + WS_LF) + (size_t)dir * MT * DM, (float*)(ws + (dir ? WS_OB : WS_OF)), b, h, dir, (char*)lds, tid_g); __syncthreads(); }
                    if (DBG_SLOW_SCAN == 5 || (DBG_SLOW_SCAN == 2 && dir == 0) || (DBG_SLOW_SCAN == 3 && Lr == 1) || (DBG_SLOW_SCAN == 4 && Lr == 3)) scn::scan_seq((const bf16*)(ws + WS_RQ), (const bf16*)(ws + WS_RV), (const float*)(ws + WS_LF) + (size_t)dir * MT * DM, (float*)(ws + (dir ? WS_OB : WS_OF)), b, h, dir, (char*)lds); else
                    dbg::slow_scan((const bf16*)(ws + WS_RQ), (const bf16*)(ws + WS_RV), (const float*)(ws + WS_LF) + (size_t)dir * MT * DM, (float*)(ws + (dir ? WS_OB : WS_OF)), b, h, dir, (char*)lds, tid_g);
#else
                    scn::scan_seq((const bf16*)(ws + WS_RQ), (const bf16*)(ws + WS_RV), (const float*)(ws + WS_LF) + (size_t)dir * MT * DM, (float*)(ws + (dir ? WS_OB : WS_OF)), b, h, dir, (char*)lds);
#endif
                    __syncthreads(); }
                SEAM(pb + 1);
            }
            if (IN(pb + 2)) {
                GEO(); unsigned char* ws = PWS(); const int jl = Lr >> 1;
                readout_phase((const float*)(ws + WS_OF), (const float*)(ws + WS_OB), (const bf16*)(ws + WS_RG), PIN(14) + jl * 128, (bf16*)(ws + WS_O), Lr == DEPTH - 1 ? ML : MT, lane, gw, NGW);
                SEAM(pb + 2);
            }
        }
        if (IN(pb + 3)) {
            GEO(); unsigned char* ws = PWS(); const int jl = Lr >> 1, Mrows = (Lr == DEPTH - 1) ? ML : MT;
            float* X = (float*)(ws + WS_X);
            const bf16* Wt = (Lr & 1) ? (const bf16*)(ws + WS_WRO) + (size_t)jl * DM * DM : (const bf16*)(ws + WS_WAO) + (size_t)jl * DM * DM;
            pg8::Gemm g{(const bf16*)(ws + WS_O), Wt, Mrows, DM, DM}; pg8::StaticOrder S; S.init(Mrows, DM, G, bx);
            pg8::EpiRes E{Lr == 0 ? PIN(0) : X, Lr == 0 ? PIN(2) : X + (size_t)ML * DM, X, (const float*)(ws + WS_MOD) + (size_t)Lr * 9 * NMOD + 2 * DM};
            pg8::gemm_phase<pg8::EpiRes, pg8::StaticOrder, true, true>(L, g, S, E);
            SEAM(pb + 3);
        }
        if (IN(pb + 4)) { GEO(); unsigned char* ws = PWS(); float* X = (float*)(ws + WS_X);
            norm_phase(X, X + (size_t)ML * DM, (bf16*)(ws + WS_H), PIN(7) + Lr * DM, (const float*)(ws + WS_MOD) + (size_t)Lr * 9 * NMOD, 3, (Lr == DEPTH - 1) ? ML : MT, lane, gw, NGW); SEAM(pb + 4); }
        if (IN(pb + 5)) {
            GEO(); unsigned char* ws = PWS(); const int Mrows = (Lr == DEPTH - 1) ? ML : MT;
            pg8::Gemm g{(const bf16*)(ws + WS_H), (const bf16*)(ws + WS_WUP) + (size_t)Lr * DFF * DM, Mrows, DFF, DM}; pg8::StaticOrder S; S.init(Mrows, DFF, G, bx);
            pg8::EpiUp E{(bf16*)(ws + WS_U), DFF};
            pg8::gemm_phase<pg8::EpiUp, pg8::StaticOrder, true, true>(L, g, S, E);
            SEAM(pb + 5);
        }
        if (IN(pb + 6)) {
            GEO(); unsigned char* ws = PWS(); const int Mrows = (Lr == DEPTH - 1) ? ML : MT; float* X = (float*)(ws + WS_X);
            pg8::Gemm g{(const bf16*)(ws + WS_U), (const bf16*)(ws + WS_WDN) + (size_t)Lr * DM * DFF, Mrows, DM, DFF}; pg8::StaticOrder S; S.init(Mrows, DM, G, bx);
            pg8::EpiRes E{X, X + (size_t)ML * DM, X, (const float*)(ws + WS_MOD) + (size_t)Lr * 9 * NMOD + 5 * DM};
            pg8::gemm_phase<pg8::EpiRes, pg8::StaticOrder, true, true>(L, g, S, E);
            SEAM(pb + 6);
        }
        if (IN(pb + 7)) {
            GEO(); unsigned char* ws = PWS(); float* X = (float*)(ws + WS_X);
            if (Lr != DEPTH - 1) norm_phase(X, X + (size_t)ML * DM, (bf16*)(ws + WS_H), PIN(6) + (Lr + 1) * DM, (const float*)(ws + WS_MOD) + (size_t)(Lr + 1) * 9 * NMOD, 0, MT, lane, gw, NGW);
            else final_norm_phase(X, PIN(17), (float*)(GAS float*)ld_u64(PT, 18), lane, gw, NGW);
            SEAM(pb + 7);
        }
    }
#undef IN
#undef SEAM
#undef GEO
}

#ifndef MK_ONE_LAUNCH
#define MK_ONE_LAUNCH 1
#endif
extern "C" void kernel_launch(void* const* d_in, const int* in_sizes, int n_in, void* d_out, int out_size, void* d_ws, size_t ws_size, hipStream_t stream) {
    static int grid = 0;
    if (grid == 0) {
        if (n_in != 18 || in_sizes[0] != ML * DM || out_size != ML * DM || ws_size < WS_END) {
            fprintf(stderr, "kernel_launch: shape mismatch: n_in %d in0 %d out %d ws %zu (need %zu)\n", n_in, n_in > 0 ? in_sizes[0] : -1, out_size, ws_size, (size_t)WS_END); grid = -1; return; }
        int dev = 0, cus = 0, per_cu = 0;
        if (hipGetDevice(&dev) != hipSuccess || hipDeviceGetAttribute(&cus, hipDeviceAttributeMultiprocessorCount, dev) != hipSuccess) { fprintf(stderr, "kernel_launch: device query failed\n"); grid = -1; return; }
        if (hipFuncSetAttribute((const void*)mk_fwd, hipFuncAttributeMaxDynamicSharedMemorySize, LDS_BYTES) != hipSuccess) { fprintf(stderr, "kernel_launch: hipFuncSetAttribute failed\n"); grid = -1; return; }
        if (hipOccupancyMaxActiveBlocksPerMultiprocessor(&per_cu, (const void*)mk_fwd, NWAVES * 64, LDS_BYTES) != hipSuccess || per_cu < 1)
            fprintf(stderr, "kernel_launch: note: occupancy query reports %d workgroups per CU\n", per_cu);
        (void)hipGetLastError();
        grid = cus;
    }
    if (grid < 0) return;
    if (hipMemsetAsync((char*)d_ws + WS_CTL, 0, CTL_ZERO_BYTES, stream) != hipSuccess) { fprintf(stderr, "kernel_launch: memset failed\n"); return; }
    KArgs a{};
    for (int i = 0; i < 18; ++i) a.in[i] = (const float*)d_in[i];
    a.out = (float*)d_out; a.ws = (unsigned char*)d_ws;
#if MK_ONE_LAUNCH
    a.ph_lo = 0; a.ph_hi = N_PHASES;
    hipLaunchKernelGGL(mk_fwd, dim3(grid), dim3(NWAVES * 64), LDS_BYTES, stream, a);
#else
    for (int ph = 0; ph < N_PHASES; ++ph) {
        if (ph >= 3) { const int Lr = (ph - 3) / 8, s = (ph - 3) % 8; if ((Lr & 1) == 0 && s == 2) continue; }
        a.ph_lo = ph; a.ph_hi = ph + 1;
        hipLaunchKernelGGL(mk_fwd, dim3(grid), dim3(NWAVES * 64), LDS_BYTES, stream, a);
    }
#endif
    const hipError_t le = hipPeekAtLastError();
    if (le != hipSuccess) fprintf(stderr, "kernel_launch: launch failed: %s\n", hipGetErrorName(le));
}
```

```cpp
#include <hip/hip_runtime.h>
#include <cstdio>
#include <cstdint>
#include <cmath>

namespace pg8 {
#define PG8_LAS __attribute__((address_space(3)))
typedef unsigned short bf16_t;
typedef short bf16x8 __attribute__((ext_vector_type(8)));
typedef float f32x4 __attribute__((ext_vector_type(4)));
typedef unsigned u32x4 __attribute__((ext_vector_type(4)));
typedef unsigned u32x2 __attribute__((ext_vector_type(2)));
constexpr int BM = 256, BK = 64, HALF = 128, HTB = HALF * BK * 2  , STAGE_BYTES = 8 * HTB, NXCD = 8, WGM = 4;

__host__ __device__ __forceinline__ int lds_byte(int r, int c) { const int st = (r >> 4) * 2 + (c >> 5), rr = r & 15, cc = c & 31, ob = rr * 64 + cc * 2; return st * 1024 + (ob ^ (((ob >> 9) & 1) << 5)); }
__host__ __device__ __forceinline__ void stage_rc(int b, int& R, int& C) { const int st = b / 1024, sb = b % 1024, swz = sb ^ (((sb >> 9) & 1) << 5); R = (st >> 1) * 16 + swz / 64; C = (st & 1) * 32 + (swz % 64) / 2; }
__host__ __device__ __forceinline__ int perm32(int rho) { const int n = rho >> 4, i = rho & 15; return 8 * (i >> 2) + 4 * n + (i & 3); }

struct Unit { int pm, pn, kofs; };
struct Gemm { const bf16_t* A; const bf16_t* Bt; int M, N, K, ld; };


struct SplitKCtxOrder {
    int G, c, ks;
    __host__ __device__ void init(int G_, int c_, int ks_) { G = G_; c = c_; ks = ks_; }
    __host__ __device__ bool next(int i, Unit& u) const {
        const int idx = i * G + c; if (idx >= 256) return false;
        const int t = idx >> 2; u.pm = 64 + (t >> 3); u.pn = t & 7; u.kofs = (idx & 3) * ks; return true;
    }
    __device__ __forceinline__ void a_ready(const Unit&) const {}
    __device__ __forceinline__ void done(const Unit&) const {}
};
struct StaticOrder {
    int nM, nN, nwg, G, c;
    __host__ __device__ void init(int M, int N, int G_, int c_) { nM = M / BM; nN = N / BM; nwg = nM * nN; G = G_; c = c_; }
    __host__ __device__ bool next(int i, Unit& u) const { return map((long)i * G + c, u); }
    __host__ __device__ bool map(long L, Unit& u) const {
        if (L >= nwg) return false;
        int wgid = (int)L; { const int q = nwg / NXCD, r = nwg % NXCD, xcd = wgid % NXCD, off = wgid / NXCD; wgid = (xcd < r ? xcd * (q + 1) : r * (q + 1) + (xcd - r) * q) + off; }
        const int nig = WGM * nN, gid = wgid / nig, fm = gid * WGM, gsz = (nM - fm) < WGM ? (nM - fm) : WGM;
        u.pm = fm + ((wgid % nig) % gsz); u.pn = (wgid % nig) / gsz; u.kofs = 0; return true;
    }
    __device__ __forceinline__ void a_ready(const Unit&) const {}
    __device__ __forceinline__ void done(const Unit&) const {}
};
struct RecOrder {
    StaticOrder lat, ctx; int G, c;
    __host__ __device__ void init(int G_, int c_) { G = G_; c = c_; lat.init(16384, 10240, G_, c_); ctx.init(2048, 8192, G_, c_); }
    __host__ __device__ bool next(int i, Unit& u) const {
        long L = (long)i * G + c; if (L < lat.nwg) return lat.map(L, u);
        L -= lat.nwg; if (!ctx.map(L, u)) return false;
        u.pm += 64; return true;
    }
    __device__ __forceinline__ void a_ready(const Unit&) const {}
    __device__ __forceinline__ void done(const Unit&) const {}
};


__device__ __forceinline__ unsigned cvt_pk_bf16(float lo, float hi) { unsigned r; asm volatile("v_cvt_pk_bf16_f32 %0, %1, %2" : "=v"(r) : "v"(lo), "v"(hi)); return r; }
__device__ __forceinline__ float fast_sigmoid(float x) { return __builtin_amdgcn_rcpf(1.0f + __expf(-x)); }
__device__ __forceinline__ float fast_silu(float x) { return x * fast_sigmoid(x); }

constexpr int E_ML = 16384;
constexpr int E_DM = 2048, E_NMOD = 12288;

typedef _Float16 f16_t;
typedef _Float16 f16x8 __attribute__((ext_vector_type(8)));
struct EpiRes {
    static constexpr bool PERM = true, AFTER_DRAIN = false;
    f16_t* X; const float* gate;
    __device__ __forceinline__ void operator()(const f32x4 (&acc)[2][2][4][2], const Unit& u, int wr, int wc, int fr, int fq) const {
        const int row0 = u.pm * BM + wr * 64 + fr, col0 = u.pn * BM + wc * 32 + 8 * fq;
        const int r9 = (u.pm < (E_ML / BM)) ? (u.pm >> 3) : 8;
        const float* gp = gate + (size_t)r9 * E_NMOD + col0;
        f32x4 gv[2][2];
#pragma unroll
        for (int bj = 0; bj < 2; ++bj)
#pragma unroll
            for (int n = 0; n < 2; ++n) gv[bj][n] = *(const f32x4*)(gp + bj * HALF + 4 * n);
        f16_t* xp = X + (size_t)row0 * E_DM + col0;
#pragma unroll
        for (int ai = 0; ai < 2; ++ai) {
            f16x8 xv[4][2];
#pragma unroll
            for (int m = 0; m < 4; ++m)
#pragma unroll
                for (int bj = 0; bj < 2; ++bj) xv[m][bj] = *(const f16x8*)(xp + (size_t)(ai * HALF + m * 16) * E_DM + bj * HALF);
#pragma unroll
            for (int m = 0; m < 4; ++m)
#pragma unroll
                for (int bj = 0; bj < 2; ++bj) { f16x8 r;
#pragma unroll
                    for (int j = 0; j < 4; ++j) { r[j] = (f16_t)((float)xv[m][bj][j] + gv[bj][0][j] * acc[ai][bj][m][0][j]); r[4 + j] = (f16_t)((float)xv[m][bj][4 + j] + gv[bj][1][j] * acc[ai][bj][m][1][j]); }
                    *(f16x8*)(xp + (size_t)(ai * HALF + m * 16) * E_DM + bj * HALF) = r; }
            asm volatile("" ::: "memory"); }
    }
};
struct EpiUp {
    static constexpr bool PERM = true, AFTER_DRAIN = false;
    bf16_t* O; int ldc;
    __device__ __forceinline__ void operator()(const f32x4 (&acc)[2][2][4][2], const Unit& u, int wr, int wc, int fr, int fq) const {
        const int row0 = u.pm * BM + wr * 64 + fr, col0 = u.pn * BM + wc * 32 + 8 * fq;
#pragma unroll
        for (int ai = 0; ai < 2; ++ai)
#pragma unroll
            for (int m = 0; m < 4; ++m) { bf16_t* rowp = O + (size_t)(row0 + ai * HALF + m * 16) * ldc + col0;
#pragma unroll
                for (int bj = 0; bj < 2; ++bj) { f32x4 v0 = acc[ai][bj][m][0], v1 = acc[ai][bj][m][1], m0, m1;
#pragma unroll
                    for (int j = 0; j < 4; ++j) { asm("v_max_f32 %0, 0, %1" : "=v"(m0[j]) : "v"(v0[j])); asm("v_max_f32 %0, 0, %1" : "=v"(m1[j]) : "v"(v1[j])); }
                    v0 = v0 * m0; v1 = v1 * m1;
                    u32x4 w; w.x = cvt_pk_bf16(v0[0], v0[1]); w.y = cvt_pk_bf16(v0[2], v0[3]); w.z = cvt_pk_bf16(v1[0], v1[1]); w.w = cvt_pk_bf16(v1[2], v1[3]);
                    *(u32x4*)(rowp + bj * HALF) = w; } }
    }
};
struct EpiQkv {
    static constexpr bool PERM = true, AFTER_DRAIN = false;
    bf16_t* O; const float* cosT; const float* sinT;
    __device__ __forceinline__ void operator()(const f32x4 (&acc)[2][2][4][2], const Unit& u, int wr, int wc, int fr, int fq) const {
        const int row0 = u.pm * BM + wr * 64 + fr, col0 = u.pn * BM + wc * 32 + 8 * fq;
        const bool rope = (u.pn < 10) && (u.pm < (E_ML / BM));
        const int axis = wc >> 1, i0 = ((wc & 1) * 4 + fq) * 4;
#pragma unroll
        for (int ai = 0; ai < 2; ++ai)
#pragma unroll
            for (int m = 0; m < 4; ++m) { const int row = row0 + ai * HALF + m * 16; bf16_t* rowp = O + (size_t)row * 3072 + col0;
                f32x4 c4 = (f32x4){1.f, 1.f, 1.f, 1.f}, s4 = (f32x4){0.f, 0.f, 0.f, 0.f};
                if (rope) { const int t = row & 2047; const int pos = axis ? (t & 63) : (t >> 6); c4 = *(const f32x4*)(cosT + pos * 32 + i0); s4 = *(const f32x4*)(sinT + pos * 32 + i0); }
#pragma unroll
                for (int bj = 0; bj < 2; ++bj) { const f32x4 v0 = acc[ai][bj][m][0], v1 = acc[ai][bj][m][1];
                    const f32x4 o0 = v0 * c4 - v1 * s4, o1 = v1 * c4 + v0 * s4;
                    u32x4 w; w.x = cvt_pk_bf16(o0[0], o0[1]); w.y = cvt_pk_bf16(o0[2], o0[3]); w.z = cvt_pk_bf16(o1[0], o1[1]); w.w = cvt_pk_bf16(o1[2], o1[3]);
                    *(u32x4*)(rowp + bj * HALF) = w; } }
    }
};
struct EpiRec {
    static constexpr bool PERM = true, AFTER_DRAIN = false;
    bf16_t* RQ; bf16_t* RV; bf16_t* RG; f16_t* LF; const float* LB; size_t lf_stride; bool lb_zero;
    __device__ __forceinline__ void operator()(const f32x4 (&acc)[2][2][4][2], const Unit& u, int wr, int wc, int fr, int fq) const {
        const int seg = u.pn >> 3;
        const int row0 = u.pm * BM + wr * 64 + fr, col0 = (u.pn & 7) * BM + wc * 32 + 8 * fq;
        if (seg == 2 || seg == 3) {
            const int dir = seg - 2; f16_t* base = LF + (size_t)dir * lf_stride;
            f32x4 lb[2][2];
#pragma unroll
            for (int bj = 0; bj < 2; ++bj)
#pragma unroll
                for (int n = 0; n < 2; ++n) lb[bj][n] = *(const f32x4*)(LB + dir * E_DM + col0 + bj * HALF + 4 * n);
#define EPIREC_F_LOOP(EXPR) _Pragma("unroll") for (int ai = 0; ai < 2; ++ai) _Pragma("unroll") for (int m = 0; m < 4; ++m) { f16_t* rowp = base + (size_t)(row0 + ai * HALF + m * 16) * E_DM + col0; \
                _Pragma("unroll") for (int bj = 0; bj < 2; ++bj) { f16x8 o; \
                    _Pragma("unroll") for (int n = 0; n < 2; ++n) { const f32x4 z = acc[ai][bj][m][n]; \
                        _Pragma("unroll") for (int j = 0; j < 4; ++j) { const float zc = fmaxf(z[j], -80.f); const float l = lb[bj][n][j]; (void)l; o[4 * n + j] = (f16_t)(EXPR); } } \
                    *(f16x8*)(rowp + bj * HALF) = o; } }
            if (lb_zero) { EPIREC_F_LOOP(-__builtin_amdgcn_logf(1.0f + __expf(-zc))) }
            else { EPIREC_F_LOOP(__builtin_amdgcn_logf(l + (1.0f - l) * fast_sigmoid(zc))) }
#undef EPIREC_F_LOOP
        } else {
            bf16_t* O = RQ + (size_t)(seg == 4 ? 2 : seg) * ((size_t)72 << 19);
            const bool act = seg == 0;
#pragma unroll
            for (int ai = 0; ai < 2; ++ai)
#pragma unroll
                for (int m = 0; m < 4; ++m) { bf16_t* rowp = O + (size_t)(row0 + ai * HALF + m * 16) * E_DM + col0;
#pragma unroll
                    for (int bj = 0; bj < 2; ++bj) { f32x4 v0 = acc[ai][bj][m][0], v1 = acc[ai][bj][m][1];
                        if (act) {
#pragma unroll
                            for (int j = 0; j < 4; ++j) { v0[j] = fast_silu(v0[j]); v1[j] = fast_silu(v1[j]); } }
                        u32x4 w; w.x = cvt_pk_bf16(v0[0], v0[1]); w.y = cvt_pk_bf16(v0[2], v0[3]); w.z = cvt_pk_bf16(v1[0], v1[1]); w.w = cvt_pk_bf16(v1[2], v1[3]);
                        *(u32x4*)(rowp + bj * HALF) = w; } }
        }
    }
};


struct EpiPart {
    static constexpr bool PERM = true, AFTER_DRAIN = false;
    f16_t* slab; int ks;
    __device__ __forceinline__ void operator()(const f32x4 (&acc)[2][2][4][2], const Unit& u, int wr, int wc, int fr, int fq) const {
        const int s = u.kofs / ks;
        const int row0 = (u.pm - E_ML / BM) * BM + wr * 64 + fr, col0 = u.pn * BM + wc * 32 + 8 * fq;
        f16_t* op = slab + ((size_t)s * 2048 + row0) * E_DM + col0;
#pragma unroll
        for (int ai = 0; ai < 2; ++ai)
#pragma unroll
            for (int m = 0; m < 4; ++m)
#pragma unroll
                for (int bj = 0; bj < 2; ++bj) { f16x8 r;
#pragma unroll
                    for (int j = 0; j < 4; ++j) { r[j] = (f16_t)acc[ai][bj][m][0][j]; r[4 + j] = (f16_t)acc[ai][bj][m][1][j]; }
                    *(f16x8*)(op + (size_t)(ai * HALF + m * 16) * E_DM + bj * HALF) = r; }
    }
};

template <class Epi, class Sched, bool ALIGN_EPI = false, bool SP2 = false>
__device__ __forceinline__ void gemm_phase(PG8_LAS unsigned char* lds, const Gemm g, const Sched& S, const Epi& E) {
    int tid_o = threadIdx.x; asm volatile("" : "+v"(tid_o));
    const int tid = tid_o, wid = __builtin_amdgcn_readfirstlane(tid >> 6), lane = tid & 63, wr = wid >> 2, wc = wid & 3, fr = lane & 15, fq = lane >> 4;
    const int K = g.K, nt = K / BK, LD = g.ld;
    unsigned voffA[2], voffB[2];
#pragma unroll
    for (int i = 0; i < 2; ++i) { int R, C; stage_rc(tid * 16 + i * 8192, R, C); const int Rb = Epi::PERM ? ((R & ~31) + perm32(R & 31)) : R;
        voffA[i] = (unsigned)(R * LD + C) * 2u; voffB[i] = (unsigned)(Rb * LD + C) * 2u; }
    const size_t kstep = (size_t)(BK * 2);
    const size_t hstep = (size_t)HALF * LD * 2;
    const size_t tstep = 2 * hstep;
    const unsigned ldsw = (unsigned)wid * 1024u;
    const int aoff = lds_byte(wr * 64 + fr, fq * 8), boff = lds_byte(wc * 32 + fr, fq * 8);
#define PG8_SA(b, h) (((b) * 2 + (h)) * HTB)
#define PG8_SB(b, h) ((4 + (b) * 2 + (h)) * HTB)
#define PG8_STAGE(bufoff, gbase, voff) do { _Pragma("unroll") for (int _i = 0; _i < 2; ++_i) \
        __builtin_amdgcn_global_load_lds((const unsigned*)((const char*)(gbase) + (voff)[_i]), (PG8_LAS unsigned*)(lds + (bufoff) + ldsw + _i * 8192), 16, 0, 0); } while (0)
#define PG8_LDA(dst, b, h) do { _Pragma("unroll") for (int m = 0; m < 4; ++m) _Pragma("unroll") for (int k = 0; k < 2; ++k) dst[m][k] = *(const PG8_LAS bf16x8*)(lds + PG8_SA(b, h) + aoff + m * 2048 + k * 1024); } while (0)
#define PG8_LDB(dst, b, h) do { _Pragma("unroll") for (int n = 0; n < 2; ++n) _Pragma("unroll") for (int k = 0; k < 2; ++k) dst[n][k] = *(const PG8_LAS bf16x8*)(lds + PG8_SB(b, h) + boff + n * 2048 + k * 1024); } while (0)
#define PG8_MMA(ai, bj, At, Bt) do { __builtin_amdgcn_s_setprio(1); _Pragma("unroll") for (int m = 0; m < 4; ++m) _Pragma("unroll") for (int n = 0; n < 2; ++n) _Pragma("unroll") for (int k = 0; k < 2; ++k) \
        acc[ai][bj][m][n] = __builtin_amdgcn_mfma_f32_16x16x32_bf16(Bt[n][k], At[m][k], acc[ai][bj][m][n], 0, 0, 0); __builtin_amdgcn_s_setprio(0); } while (0)
#define PG8_MMAZ(ai, bj, At, Bt) do { __builtin_amdgcn_s_setprio(1); \
        asm volatile("v_mfma_f32_16x16x32_bf16 %0, %16, %8, 0\n\tv_mfma_f32_16x16x32_bf16 %1, %18, %8, 0\n\tv_mfma_f32_16x16x32_bf16 %2, %16, %10, 0\n\tv_mfma_f32_16x16x32_bf16 %3, %18, %10, 0\n\tv_mfma_f32_16x16x32_bf16 %4, %16, %12, 0\n\tv_mfma_f32_16x16x32_bf16 %5, %18, %12, 0\n\tv_mfma_f32_16x16x32_bf16 %6, %16, %14, 0\n\tv_mfma_f32_16x16x32_bf16 %7, %18, %14, 0\n\tv_mfma_f32_16x16x32_bf16 %0, %17, %9, %0\n\tv_mfma_f32_16x16x32_bf16 %1, %19, %9, %1\n\tv_mfma_f32_16x16x32_bf16 %2, %17, %11, %2\n\tv_mfma_f32_16x16x32_bf16 %3, %19, %11, %3\n\tv_mfma_f32_16x16x32_bf16 %4, %17, %13, %4\n\tv_mfma_f32_16x16x32_bf16 %5, %19, %13, %5\n\tv_mfma_f32_16x16x32_bf16 %6, %17, %15, %6\n\tv_mfma_f32_16x16x32_bf16 %7, %19, %15, %7" \
            : "+v"(acc[ai][bj][0][0]), "+v"(acc[ai][bj][0][1]), "+v"(acc[ai][bj][1][0]), "+v"(acc[ai][bj][1][1]), "+v"(acc[ai][bj][2][0]), "+v"(acc[ai][bj][2][1]), "+v"(acc[ai][bj][3][0]), "+v"(acc[ai][bj][3][1]) \
            : "v"(At[0][0]), "v"(At[0][1]), "v"(At[1][0]), "v"(At[1][1]), "v"(At[2][0]), "v"(At[2][1]), "v"(At[3][0]), "v"(At[3][1]), "v"(Bt[0][0]), "v"(Bt[0][1]), "v"(Bt[1][0]), "v"(Bt[1][1])); \
        __builtin_amdgcn_s_setprio(0); } while (0)
#define PG8_WAIT_V(n) asm volatile("s_waitcnt vmcnt(" #n ")" ::: "memory")
#define PG8_WAIT_L(n) asm volatile("s_waitcnt lgkmcnt(" #n ")" ::: "memory")
#define PG8_BAR __builtin_amdgcn_s_barrier()
#define PG8_SCHED __builtin_amdgcn_sched_barrier(0)
    Unit cur, nxt; int ui = 0;
    if (!S.next(0, cur)) return;
    f32x4 acc[2][2][4][2];
    {
#pragma unroll
    for (int a = 0; a < 2; ++a)
#pragma unroll
        for (int b = 0; b < 2; ++b)
#pragma unroll
            for (int m = 0; m < 4; ++m)
#pragma unroll
                for (int n = 0; n < 2; ++n) acc[a][b][m][n] = (f32x4){0.f, 0.f, 0.f, 0.f};
    }
    bf16x8 At[4][2], B0[2][2], B1[2][2];
    const char* cA = (const char*)g.A + (size_t)cur.pm * tstep + (size_t)cur.kofs * 2; const char* cB = (const char*)g.Bt + (size_t)cur.pn * tstep + (size_t)cur.kofs * 2;
    S.a_ready(cur);
    if constexpr (SP2) {
        PG8_STAGE(PG8_SB(0, 0), cB, voffB); PG8_STAGE(PG8_SB(0, 1), cB + hstep, voffB); PG8_STAGE(PG8_SA(0, 0), cA, voffA); PG8_STAGE(PG8_SA(0, 1), cA + hstep, voffA);
        if (wr == 1) PG8_BAR;
        PG8_WAIT_V(2); PG8_BAR;
        PG8_STAGE(PG8_SB(1, 0), cB + kstep, voffB); PG8_STAGE(PG8_SA(1, 0), cA + kstep, voffA); PG8_STAGE(PG8_SB(1, 1), cB + hstep + kstep, voffB);
        PG8_WAIT_V(6); PG8_BAR;
    } else {
        PG8_STAGE(PG8_SB(0, 0), cB, voffB); PG8_STAGE(PG8_SA(0, 0), cA, voffA); PG8_STAGE(PG8_SB(0, 1), cB + hstep, voffB); PG8_STAGE(PG8_SA(0, 1), cA + hstep, voffA);
        if (wr == 1) PG8_BAR;
        PG8_WAIT_V(4); PG8_BAR;
        PG8_STAGE(PG8_SB(1, 0), cB + kstep, voffB); PG8_STAGE(PG8_SA(1, 0), cA + kstep, voffA); PG8_STAGE(PG8_SB(1, 1), cB + hstep + kstep, voffB);
        PG8_WAIT_V(6); PG8_BAR;
    }
    for (;;) {
        const bool has_next = S.next(ui + 1, nxt);
        const char* nA = has_next ? (const char*)g.A + (size_t)nxt.pm * tstep + (size_t)nxt.kofs * 2 : cA; const char* nB = has_next ? (const char*)g.Bt + (size_t)nxt.pn * tstep + (size_t)nxt.kofs * 2 : cB;
#define PG8_KSETUP(t) const bool last = ((t) == nt - 2); \
            const char* a1 = cA + (size_t)((t) + 1) * kstep;                                           \
            const char* a2 = last ? nA : cA + (size_t)((t) + 2) * kstep; const char* b2 = last ? nB : cB + (size_t)((t) + 2) * kstep;     \
            const char* a3 = a2 + kstep; const char* b3 = b2 + kstep;                                \
            if (last && has_next) S.a_ready(nxt);
#define PG8_KBODY(MF) \
            PG8_LDB(B0, 0, 0); PG8_LDB(B1, 0, 1); PG8_SCHED; PG8_LDA(At, 0, 0); PG8_STAGE(PG8_SA(1, 1), a1 + hstep, voffA); \
            PG8_WAIT_V(8); PG8_WAIT_L(0); PG8_BAR; MF(0, 0, At, B0); MF(0, 1, At, B1); PG8_BAR; PG8_SCHED; \
            PG8_LDA(At, 0, 1); PG8_STAGE(PG8_SB(0, 0), b2, voffB); PG8_STAGE(PG8_SB(0, 1), b2 + hstep, voffB); PG8_STAGE(PG8_SA(0, 0), a2, voffA); \
            PG8_WAIT_V(8); PG8_WAIT_L(0); PG8_BAR; MF(1, 0, At, B0); MF(1, 1, At, B1); PG8_BAR; PG8_SCHED; \
            PG8_LDB(B0, 1, 0); PG8_LDB(B1, 1, 1); PG8_SCHED; PG8_LDA(At, 1, 0); PG8_STAGE(PG8_SA(0, 1), a2 + hstep, voffA); \
            PG8_WAIT_V(8); PG8_WAIT_L(0); PG8_BAR; PG8_MMA(0, 0, At, B0); PG8_MMA(0, 1, At, B1); PG8_BAR; PG8_SCHED; \
            PG8_LDA(At, 1, 1); PG8_STAGE(PG8_SB(1, 0), b3, voffB); PG8_STAGE(PG8_SB(1, 1), b3 + hstep, voffB); PG8_STAGE(PG8_SA(1, 0), a3, voffA); \
            PG8_WAIT_V(8); PG8_WAIT_L(0); PG8_BAR; PG8_MMA(1, 0, At, B0); PG8_MMA(1, 1, At, B1); PG8_BAR; PG8_SCHED;
        if constexpr (SP2) {
            { PG8_KSETUP(0) PG8_KBODY(PG8_MMAZ) }
            for (int t = 2; t < nt; t += 2) { PG8_KSETUP(t) PG8_KBODY(PG8_MMA) }
        } else
        for (int t = 0; t < nt; t += 2) {
            const bool last = (t == nt - 2);
            const char* a1 = cA + (size_t)(t + 1) * kstep;
            const char* a2 = last ? nA : cA + (size_t)(t + 2) * kstep; const char* b2 = last ? nB : cB + (size_t)(t + 2) * kstep;
            const char* a3 = a2 + kstep; const char* b3 = b2 + kstep;
            if (last && has_next) S.a_ready(nxt);
            {
            PG8_LDB(B0, 0, 0); PG8_SCHED; PG8_LDA(At, 0, 0); PG8_STAGE(PG8_SA(1, 1), a1 + hstep, voffA);
            PG8_WAIT_L(8); PG8_BAR; PG8_WAIT_L(0); PG8_MMA(0, 0, At, B0); PG8_BAR; PG8_SCHED;
            PG8_LDB(B1, 0, 1); PG8_STAGE(PG8_SB(0, 0), b2, voffB);
            PG8_BAR; PG8_WAIT_L(0); PG8_MMA(0, 1, At, B1); PG8_BAR;
            PG8_LDA(At, 0, 1); PG8_STAGE(PG8_SA(0, 0), a2, voffA);
            PG8_BAR; PG8_WAIT_L(0); PG8_MMA(1, 0, At, B0); PG8_BAR; PG8_SCHED;
            PG8_STAGE(PG8_SB(0, 1), b2 + hstep, voffB);
            PG8_WAIT_V(6); PG8_BAR; PG8_MMA(1, 1, At, B1); PG8_BAR;
            PG8_LDB(B0, 1, 0); PG8_SCHED; PG8_LDA(At, 1, 0); PG8_STAGE(PG8_SA(0, 1), a2 + hstep, voffA);
            PG8_WAIT_L(8); PG8_BAR; PG8_WAIT_L(0); PG8_MMA(0, 0, At, B0); PG8_BAR; PG8_SCHED;
            PG8_LDB(B1, 1, 1); PG8_STAGE(PG8_SB(1, 0), b3, voffB);
            PG8_BAR; PG8_WAIT_L(0); PG8_MMA(0, 1, At, B1); PG8_BAR;
            PG8_LDA(At, 1, 1); PG8_STAGE(PG8_SA(1, 0), a3, voffA);
            PG8_BAR; PG8_WAIT_L(0); PG8_MMA(1, 0, At, B0); PG8_BAR; PG8_SCHED;
            PG8_STAGE(PG8_SB(1, 1), b3 + hstep, voffB);
            PG8_WAIT_V(6); PG8_BAR; PG8_MMA(1, 1, At, B1); PG8_BAR;
            }
        }
        if constexpr (ALIGN_EPI) { if (wr == 0) PG8_BAR; }
        if constexpr (!Epi::AFTER_DRAIN) { E(acc, cur, wr, wc, fr, fq); S.done(cur); }
        if (!has_next) break;
        if constexpr (!SP2) {
#pragma unroll
        for (int a = 0; a < 2; ++a)
#pragma unroll
            for (int b = 0; b < 2; ++b)
#pragma unroll
                for (int m = 0; m < 4; ++m)
#pragma unroll
                    for (int n = 0; n < 2; ++n) acc[a][b][m][n] = (f32x4){0.f, 0.f, 0.f, 0.f};
        }
        cur = nxt; cA = nA; cB = nB; ++ui;
        if constexpr (ALIGN_EPI) { if (wr == 1) PG8_BAR; }
    }
    PG8_WAIT_V(0);
    if constexpr (!ALIGN_EPI) { if (wr == 0) PG8_BAR; }
    PG8_BAR;
    if constexpr (Epi::AFTER_DRAIN) { E.fused(acc, cur, wr, wc, fr, fq, lds, wid, lane); S.done(cur); }
#undef PG8_SA
#undef PG8_SB
#undef PG8_STAGE
#undef PG8_LDA
#undef PG8_LDB
#undef PG8_MMA
#undef PG8_MMAZ
#undef PG8_KSETUP
#undef PG8_KBODY
#undef PG8_WAIT_V
#undef PG8_WAIT_L
#undef PG8_BAR
#undef PG8_SCHED
}
}

#define GAS __attribute__((address_space(1)))
#define LAS __attribute__((address_space(3)))
typedef unsigned short bf16;
typedef unsigned v4u __attribute__((ext_vector_type(4)));
typedef float f32x4 __attribute__((ext_vector_type(4)));
typedef short bf16x8 __attribute__((ext_vector_type(8)));
typedef GAS unsigned gu32;
typedef GAS unsigned long long gu64;
#define RLX_AGENT __ATOMIC_RELAXED, __HIP_MEMORY_SCOPE_AGENT
#define LDS_WAIT() asm volatile("s_waitcnt lgkmcnt(0)" ::: "memory")
#define VM_WAIT() asm volatile("s_waitcnt vmcnt(0)" ::: "memory")
__device__ __forceinline__ unsigned long long rt() { return __builtin_amdgcn_s_memrealtime(); }
__device__ __forceinline__ unsigned f2bf(float f) { unsigned u = __builtin_bit_cast(unsigned, f); return (u + 0x7fffu + ((u >> 16) & 1u)) >> 16; }
__device__ __forceinline__ unsigned pk2(float lo, float hi) { return f2bf(lo) | (f2bf(hi) << 16); }

#define XB_TMO      128
#define XB_XCNT(j)  (256  + 64 * (j))
#define XB_XSUB(j)  (1280 + 64 * (j))
#define XB_XGEN(j)  (2304 + 64 * (j))
#define XB_TOP      3328
#define XB_TOPGEN   3392
#define XCD_BAR_WORDS 3456
#define XB_SPIN_CAP (1u << 18)

__device__ __forceinline__ unsigned xb_ld(unsigned* p)              { return __hip_atomic_load(p, __ATOMIC_RELAXED, __HIP_MEMORY_SCOPE_AGENT); }
__device__ __forceinline__ unsigned xb_add(unsigned* p, unsigned v) { return __hip_atomic_fetch_add(p, v, __ATOMIC_RELAXED, __HIP_MEMORY_SCOPE_AGENT); }
__device__ __forceinline__ unsigned xb_xcc_id() { return (unsigned)__builtin_amdgcn_s_getreg((3 << 11) | 20) & 0xFu; }
#define XB_SPIN(cond, bar) do { unsigned _sp = 0; while (cond) { __builtin_amdgcn_s_sleep(1); \
    if ((++_sp & 255u) == 0u) { if (xb_ld(&(bar)[XB_TMO])) break; if (_sp > XB_SPIN_CAP) { atomicAdd(&(bar)[XB_TMO], 1u); break; } } } } while (0)

struct XcdBarrier {
    unsigned* bar; unsigned x;
    volatile LAS unsigned* st;
};

__device__ __forceinline__ XcdBarrier xcd_barrier_post(unsigned* bar, volatile LAS unsigned* st) {
    XcdBarrier b; b.bar = bar; b.x = xb_xcc_id(); b.st = st;
    if (threadIdx.x == 0) (void)xb_add(&bar[XB_XCNT(b.x)], 1u);
    return b;
}
__device__ __forceinline__ void xcd_barrier_complete(unsigned* bar, unsigned x, unsigned& nloc, unsigned& nx) {
    const unsigned G = gridDim.x * gridDim.y * gridDim.z;
    unsigned sum, cnt, mine, sp = 0u;
    for (;;) {
        sum = 0u; cnt = 0u; mine = 0u;
#pragma unroll
        for (unsigned j = 0; j < 16; ++j) { const unsigned c = xb_ld(&bar[XB_XCNT(j)]); sum += c; cnt += (c > 0u) ? 1u : 0u; mine = (j == x) ? c : mine; }
        if (sum == G) break;
        __builtin_amdgcn_s_sleep(1);
        if ((++sp & 255u) == 0u) { if (xb_ld(&bar[XB_TMO])) break; if (sp > XB_SPIN_CAP) { atomicAdd(&bar[XB_TMO], 1u); break; } }
    }
    nloc = mine > 0u ? mine : 1u; nx = cnt > 0u ? cnt : 1u;
}

__device__ __forceinline__ void xcd_barrier(const XcdBarrier& b) {
    asm volatile("s_waitcnt vmcnt(0)" ::: "memory");
    __syncthreads();
    if (threadIdx.x == 0) {
        unsigned* bar = b.bar;
        __builtin_amdgcn_s_waitcnt(0);
        unsigned nloc = b.st[0], nx = b.st[1];
        if (nloc == 0u) { xcd_barrier_complete(bar, b.x, nloc, nx); b.st[0] = nloc; b.st[1] = nx; }
        const unsigned old = xb_add(&bar[XB_XSUB(b.x)], 1u);
        const unsigned gen = old / nloc;
        if (old + 1u == (gen + 1u) * nloc) {
            __builtin_amdgcn_fence(__ATOMIC_RELEASE, "agent");
            asm volatile("s_waitcnt vmcnt(0)" ::: "memory");
            const unsigned og = xb_add(&bar[XB_TOP], 1u);
            const unsigned tg = og / nx;
            if (og + 1u == (tg + 1u) * nx) xb_add(&bar[XB_TOPGEN], 1u);
            else XB_SPIN(xb_ld(&bar[XB_TOPGEN]) == tg, bar);
            __builtin_amdgcn_fence(__ATOMIC_ACQUIRE, "agent");
            xb_add(&bar[XB_XGEN(b.x)], 1u);
            asm volatile("s_waitcnt vmcnt(0)" ::: "memory");
        } else {
            XB_SPIN(xb_ld(&bar[XB_XGEN(b.x)]) == gen, bar);
            __builtin_amdgcn_fence(__ATOMIC_ACQUIRE, "agent");
            asm volatile("s_waitcnt vmcnt(0)" ::: "memory");
        }
    }
    __syncthreads();
}


namespace att {
using bf16x8 = __attribute__((ext_vector_type(8))) short;
using s16x4  = __attribute__((ext_vector_type(4))) short;
using f32x16 = __attribute__((ext_vector_type(16))) float;
using u32x4  = __attribute__((ext_vector_type(4))) unsigned;
constexpr int D = 128, NW = 8, QBLK = 32, KVBLK = 64;
constexpr int LDQ = 3072, LDO = 2048;
constexpr float SCALE = 0.088388347648318440f;
constexpr float THR = 4.f;
constexpr size_t SHM_V = KVBLK * D * 2, SHM_K = KVBLK * D * 2, NBUF = 3, SHM_ATTN = NBUF * SHM_V + NBUF * SHM_K + NW * 64 * 4;
#define KSWZ(row, colB) ((row) * 256 + ((colB) ^ (((row) & 7) << 4)))
#define SBAR() __builtin_amdgcn_sched_barrier(0)
__device__ __forceinline__ int crow(int r, int hi) { return (r & 3) + 8 * (r >> 2) + 4 * hi; }
__device__ __forceinline__ unsigned cvtpk(float lo, float hi) { unsigned r; asm volatile("v_cvt_pk_bf16_f32 %0, %1, %2" : "=v"(r) : "v"(lo), "v"(hi)); return r; }

__device__ __forceinline__ void partialSM(f32x16& p0, f32x16& p1, float& m_reg, float& mn, float& alpha) {
  constexpr float C = SCALE * 1.4426950408889634f;
  float pmax = p0[0];
#pragma unroll
  for (int r = 1; r < 16; ++r) pmax = fmaxf(pmax, p0[r]);
#pragma unroll
  for (int r = 0; r < 16; ++r) pmax = fmaxf(pmax, p1[r]);
  { auto rr = __builtin_amdgcn_permlane32_swap(__float_as_uint(pmax), __float_as_uint(pmax), false, false);
    pmax = fmaxf(__uint_as_float(rr[0]), __uint_as_float(rr[1])); }
  if (__builtin_expect(__all(pmax - m_reg <= THR / SCALE), 1)) { mn = m_reg; alpha = 1.f; }
  else { mn = fmaxf(m_reg, pmax); alpha = __builtin_amdgcn_exp2f((m_reg - mn) * C); m_reg = mn; }
  float mnC = -mn * C;
#pragma unroll
  for (int r = 0; r < 16; ++r) p0[r] = fmaf(p0[r], C, mnC);
#pragma unroll
  for (int r = 0; r < 16; ++r) p1[r] = fmaf(p1[r], C, mnC);
#pragma unroll
  for (int r = 0; r < 16; ++r) p0[r] = __builtin_amdgcn_exp2f(p0[r]);
}
__device__ __forceinline__ void finishSM(f32x16& p0, f32x16& p1, float alpha, float& l_reg, bf16x8& pa0, bf16x8& pa1, bf16x8& pa2, bf16x8& pa3) {
#pragma unroll
  for (int r = 0; r < 16; ++r) p1[r] = __builtin_amdgcn_exp2f(p1[r]);
  float ps = 0;
#pragma unroll
  for (int r = 0; r < 16; ++r) ps += p0[r];
#pragma unroll
  for (int r = 0; r < 16; ++r) ps += p1[r];
  { auto rr = __builtin_amdgcn_permlane32_swap(__float_as_uint(ps), __float_as_uint(ps), false, false);
    ps = __uint_as_float(rr[0]) + __uint_as_float(rr[1]); }
  l_reg = l_reg * alpha + ps;
#define PK4(P, BASE, OUT) do { unsigned a0 = cvtpk(P[BASE + 0], P[BASE + 1]), a1 = cvtpk(P[BASE + 2], P[BASE + 3]);   \
    unsigned b0 = cvtpk(P[BASE + 4], P[BASE + 5]), b1 = cvtpk(P[BASE + 6], P[BASE + 7]);                              \
    auto r0 = __builtin_amdgcn_permlane32_swap(a0, b0, false, false); auto r1 = __builtin_amdgcn_permlane32_swap(a1, b1, false, false); \
    u32x4 w = {r0[0], r1[0], r0[1], r1[1]}; OUT = *reinterpret_cast<bf16x8*>(&w); } while (0)
  PK4(p0, 0, pa0); PK4(p0, 8, pa1); PK4(p1, 0, pa2); PK4(p1, 8, pa3);
#undef PK4
}
__device__ __forceinline__ void qkt(f32x16& p0, f32x16& p1, const char* Ks, const bf16x8* qr, int r32, int hi) {
  p0 = f32x16{}; p1 = f32x16{};
#pragma unroll
  for (int d0 = 0; d0 < 8; ++d0) { int cb = (d0 * 16 + hi * 8) * 2;
    bf16x8 b0 = *reinterpret_cast<const bf16x8*>(Ks + KSWZ(r32, cb));
    bf16x8 b1 = *reinterpret_cast<const bf16x8*>(Ks + KSWZ(32 + r32, cb));
    p0 = __builtin_amdgcn_mfma_f32_32x32x16_bf16(b0, qr[d0], p0, 0, 0, 0);
    p1 = __builtin_amdgcn_mfma_f32_32x32x16_bf16(b1, qr[d0], p1, 0, 0, 0); }
}
__device__ __forceinline__ void mask_tile(f32x16& p0, f32x16& p1, int dlt0, int hi) {
#pragma unroll
  for (int r = 0; r < 16; ++r) { const int d = dlt0 + crow(r, hi);
    if (d < -128 || d > 128) p0[r] = -1e30f;
    if (d + 32 < -128 || d + 32 > 128) p1[r] = -1e30f; }
}
__device__ __forceinline__ int v_st(int k, int c) { const int kk = (k & ~0xC) | ((k & 4) << 1) | ((k & 8) >> 1); return ((kk >> 3) * 4 + (c >> 5)) * 512 + ((kk & 7) * 32 + (c & 31)) * 2; }
__device__ __forceinline__ int v_rd_base(int lane) { return ((lane & 3) << 3) | (((lane >> 2) & 3) << 6) | (((lane >> 4) & 1) << 5) | (((lane >> 5) & 1) << 8); }
constexpr int v_rd_off(int d0, int ks, int half) { return d0 * 512 + ks * 4096 + half * 2048; }
template <int OFF> __device__ __forceinline__ s16x4 tr_read(int vb) {
  s16x4 r; asm volatile("ds_read_b64_tr_b16 %0, %1 offset:%2" : "=&v"(r) : "v"(vb), "i"(OFF) : "memory"); return r;
}
template <int D0> __device__ __forceinline__ void pv_one(f32x16& od, int vb, bf16x8 pa0, bf16x8 pa1, bf16x8 pa2, bf16x8 pa3) {
  const s16x4 l0 = tr_read<v_rd_off(D0, 0, 0)>(vb), h0 = tr_read<v_rd_off(D0, 0, 1)>(vb), l1 = tr_read<v_rd_off(D0, 1, 0)>(vb), h1 = tr_read<v_rd_off(D0, 1, 1)>(vb);
  const s16x4 l2 = tr_read<v_rd_off(D0, 2, 0)>(vb), h2 = tr_read<v_rd_off(D0, 2, 1)>(vb), l3 = tr_read<v_rd_off(D0, 3, 0)>(vb), h3 = tr_read<v_rd_off(D0, 3, 1)>(vb);
  asm volatile("s_waitcnt lgkmcnt(0)" ::: "memory"); SBAR();
#define PK(L, H) (bf16x8){L[0], L[1], L[2], L[3], H[0], H[1], H[2], H[3]}
  od = __builtin_amdgcn_mfma_f32_32x32x16_bf16(pa0, PK(l0, h0), od, 0, 0, 0);
  od = __builtin_amdgcn_mfma_f32_32x32x16_bf16(pa1, PK(l1, h1), od, 0, 0, 0);
  od = __builtin_amdgcn_mfma_f32_32x32x16_bf16(pa2, PK(l2, h2), od, 0, 0, 0);
  od = __builtin_amdgcn_mfma_f32_32x32x16_bf16(pa3, PK(l3, h3), od, 0, 0, 0);
#undef PK
}
__device__ __forceinline__ void pv_d0(f32x16* o, int vb, bf16x8 pa0, bf16x8 pa1, bf16x8 pa2, bf16x8 pa3) {
  pv_one<0>(o[0], vb, pa0, pa1, pa2, pa3); pv_one<1>(o[1], vb, pa0, pa1, pa2, pa3); pv_one<2>(o[2], vb, pa0, pa1, pa2, pa3); pv_one<3>(o[3], vb, pa0, pa1, pa2, pa3);
}

struct UnitP { int qrow0, hd0, grp, kcol, vcol, win_row0, kpos_start, nwin, ctx_row0, qpos0, pad; };
__device__ __forceinline__ UnitP unit_params(int u) {
  constexpr int SEQ_ = 2048, ML_ = 16384, CTXL_ = 256;
  UnitP P;
  if (u < 1024) { const int qb = u & 31, hk = (u >> 5) & 3, b = u >> 7;
    const int P0 = qb * 64; const int k0 = (P0 - 128 < 0) ? 0 : P0 - 128, k1 = (P0 + 192 > SEQ_) ? SEQ_ : P0 + 192; const int n = (k1 - k0) >> 6;
    P.pad = n & 1;
    P.qrow0 = b * SEQ_ + P0; P.hd0 = hk * 4; P.grp = 1; P.kcol = 2048 + hk * 128; P.vcol = 2560 + hk * 128; P.win_row0 = b * SEQ_ + k0; P.kpos_start = k0; P.nwin = n;
    P.ctx_row0 = ML_ + b * CTXL_; P.qpos0 = P0; }
  else { const int uc = u - 1024, h = uc & 15, b = uc >> 4, hk = h >> 2;
    P.qrow0 = ML_ + b * CTXL_; P.hd0 = h; P.grp = 0; P.kcol = 2048 + hk * 128; P.vcol = 2560 + hk * 128; P.win_row0 = 0; P.kpos_start = 0; P.nwin = 0; P.ctx_row0 = ML_ + b * CTXL_; P.qpos0 = 0; P.pad = 0; }
  return P;
}
__device__ __forceinline__ int unit_at(int i, int c, int G) {
  if (G == 256) {
    if (i < 4) return c + 256 * i;
    const int qb = c & 31; const bool edge = qb < 2 || qb >= 30;
    if (edge) { const int r = ((c >> 5) << 2) + (qb < 2 ? qb : qb - 28); return i < 6 ? 1024 + 2 * r + (i - 4) : -1; }
    const int s = (c >> 5) * 28 + (qb - 2);
    return (i == 4 && s < 64) ? 1024 + 64 + s : -1;
  }
  const int u = c + G * i; return u < 1024 + 128 ? u : -1;
}
__device__ __forceinline__ void attn_units(const unsigned short* __restrict__ QKV, unsigned short* __restrict__ Og, const float* sinkp, int u0, int ustep, char* lds) {
  int tid_o = threadIdx.x; asm volatile("" : "+v"(tid_o));
  asm volatile("" : "+s"(u0));
  const int tid = tid_o, wid = __builtin_amdgcn_readfirstlane(tid >> 6), lane = tid & 63, r32 = lane & 31, hi = lane >> 5;
#define WROW(PP) ((PP).grp ? 32 * (wid & 1) : 32 * wid)
#define WHEAD(PP) ((PP).hd0 + ((PP).grp ? (wid >> 1) : 0))
  char* V_lds = lds; char* K_lds = lds + NBUF * SHM_V;
  float* ws = (float*)(lds + NBUF * SHM_V + NBUF * SHM_K) + wid * 64; float* li_l = ws; float* al_l = ws + 32;
  const int sr = tid >> 4, sc = (tid & 15) * 8, vst0 = v_st(sr, sc), vst1 = v_st(32 + sr, sc);
  const int vb0 = (int)(uintptr_t)V_lds + v_rd_base(lane);
  bf16x8 qr[8];
  struct { bf16x8 vs0, vs1, ks0, ks1; } sr_[2];
  constexpr int SE = 0, SO = 1;
#define TROWP(PP, j) ((j) < (PP).nwin ? (PP).win_row0 + 64 * (j) : (PP).ctx_row0 + 64 * (((j) - (PP).nwin) & 3))
#define SLOADP(PP, i, j) do { const unsigned short* tb_ = QKV + (size_t)(TROWP(PP, j) + sr) * LDQ + sc; \
    sr_[i].vs0 = *reinterpret_cast<const bf16x8*>(tb_ + (PP).vcol); sr_[i].vs1 = *reinterpret_cast<const bf16x8*>(tb_ + (size_t)32 * LDQ + (PP).vcol); \
    sr_[i].ks0 = *reinterpret_cast<const bf16x8*>(tb_ + (PP).kcol); sr_[i].ks1 = *reinterpret_cast<const bf16x8*>(tb_ + (size_t)32 * LDQ + (PP).kcol); } while (0)
#define QLOADP(PP) do { const unsigned short* Qw_ = QKV + (size_t)((PP).qrow0 + WROW(PP) + r32) * LDQ + WHEAD(PP) * 128 + hi * 8; \
    _Pragma("unroll") for (int d0 = 0; d0 < 8; ++d0) qr[d0] = *reinterpret_cast<const bf16x8*>(Qw_ + d0 * 16); } while (0)
#define SLOAD(i, j) SLOADP(P, i, j)
#define SWRITE(b, i) do { *(bf16x8*)(V_lds + (b) * SHM_V + vst0) = sr_[i].vs0; *(bf16x8*)(V_lds + (b) * SHM_V + vst1) = sr_[i].vs1; int kc = sc * 2; \
    *(bf16x8*)(K_lds + (b) * SHM_K + KSWZ(sr, kc)) = sr_[i].ks0; *(bf16x8*)(K_lds + (b) * SHM_K + KSWZ(32 + sr, kc)) = sr_[i].ks1; } while (0)
#define SWAIT() asm volatile("s_waitcnt vmcnt(4)" ::: "memory")
#define RESC(a) do { if (__any((a) < 1.f)) { if (hi == 0) al_l[r32] = (a); asm volatile("s_waitcnt lgkmcnt(0)" ::: "memory"); \
    _Pragma("unroll") for (int d = 0; d < 4; ++d) _Pragma("unroll") for (int r = 0; r < 16; ++r) o[d][r] *= al_l[crow(r, hi)]; } } while (0)
#define MASK(P0_, P1_, j) do { if ((j) < nwin) { const int kp0_ = P.kpos_start + 64 * (j); \
    if (!(kp0_ - (qpmin + 31) >= -128 && kp0_ + 63 - qpmin <= 128)) mask_tile(P0_, P1_, kp0_ - qpos, hi); } } while (0)
  int ucur = unit_at(0, u0, ustep);
  if (ucur < 0) return;
  UnitP P = unit_params(ucur);
  QLOADP(P); SLOADP(P, SE, 0);
  for (int ui = 0; ucur >= 0; ++ui) {
    const int unext = unit_at(ui + 1, u0, ustep);
    const bool has_next = unext >= 0;
    const UnitP PN = unit_params(has_next ? unext : ucur);
    const int nwin = P.nwin, NT = nwin + 4 + P.pad;
    const int qpos = P.qpos0 + WROW(P) + r32, qpmin = P.qpos0 + WROW(P);
    float m_reg = sinkp[WHEAD(P)] * (1.0f / SCALE), l_reg = 1.f; f32x16 o[4] = {};
    f32x16 pA0, pA1, pB0, pB1; float mnA, mnB, alA, alB; bf16x8 pa0, pa1, pa2, pa3;
#define KB(b) (K_lds + (b) * SHM_K)
#define VB(b) (vb0 + (int)((b) * SHM_V))
#define INC3(b) ((b) == 2 ? 0 : (b) + 1)
    SWRITE(0, SE); __syncthreads();
    qkt(pA0, pA1, KB(0), qr, r32, hi); MASK(pA0, pA1, 0); partialSM(pA0, pA1, m_reg, mnA, alA);
    SLOAD(SO, 1); if (2 < NT) SLOAD(SE, 2);
    SWAIT(); SWRITE(1, SO); __syncthreads();
    int bj = 1;
    for (int j = 1; j + 1 < NT; j += 2) {
      const int bp = INC3(bj), bm = INC3(bp);
      SBAR(); qkt(pB0, pB1, KB(bj), qr, r32, hi);
      finishSM(pA0, pA1, alA, l_reg, pa0, pa1, pa2, pa3); SBAR();
      SLOAD(SO, j + 2); SBAR();
      pv_d0(o, VB(bm), pa0, pa1, pa2, pa3); MASK(pB0, pB1, j); partialSM(pB0, pB1, m_reg, mnB, alB);
      SWAIT(); SWRITE(bp, SE);
      RESC(alB); __syncthreads();
      SBAR(); qkt(pA0, pA1, KB(bp), qr, r32, hi);
      finishSM(pB0, pB1, alB, l_reg, pa0, pa1, pa2, pa3); SBAR();
      if (j + 3 < NT) SLOAD(SE, j + 3); SBAR();
      pv_d0(o, VB(bj), pa0, pa1, pa2, pa3); MASK(pA0, pA1, j + 1); partialSM(pA0, pA1, m_reg, mnA, alA);
      SWAIT(); SWRITE(bm, SO);
      RESC(alA); __syncthreads();
      bj = bm;
    }
    const bool real = P.pad == 0;
    { const int bm = INC3(INC3(bj));
    SBAR(); qkt(pB0, pB1, KB(bj), qr, r32, hi);
    finishSM(pA0, pA1, alA, l_reg, pa0, pa1, pa2, pa3); SBAR();
    pv_d0(o, VB(bm), pa0, pa1, pa2, pa3);
    if (real) { MASK(pB0, pB1, NT - 1); partialSM(pB0, pB1, m_reg, mnB, alB);
      RESC(alB);
      finishSM(pB0, pB1, alB, l_reg, pa0, pa1, pa2, pa3); SBAR();
      pv_d0(o, VB(bj), pa0, pa1, pa2, pa3); } }
    if (has_next) { QLOADP(PN); SLOADP(PN, SE, 0); }
    if (hi == 0) li_l[r32] = l_reg; asm volatile("s_waitcnt lgkmcnt(0)" ::: "memory");
    float rli[16];
#pragma unroll
    for (int r = 0; r < 16; ++r) rli[r] = __builtin_amdgcn_rcpf(li_l[crow(r, hi)]);
    unsigned short* Ow = Og + (size_t)(P.qrow0 + WROW(P)) * LDO + WHEAD(P) * 128;
#pragma unroll
    for (int r = 0; r < 16; ++r) { const int orow = crow(r, hi);
#pragma unroll
      for (int d0 = 0; d0 < 4; ++d0) { const unsigned w = cvtpk(o[d0][r] * rli[r], 0.f); Ow[(size_t)orow * LDO + d0 * 32 + r32] = (unsigned short)(w & 0xffffu); } }
    __syncthreads();
    P = PN; ucur = unext;
  }
#undef KB
#undef VB
#undef INC3
#undef WROW
#undef WHEAD
#undef TROWP
#undef SLOADP
#undef QLOADP
#undef SLOAD
#undef SWRITE
#undef SWAIT
#undef RESC
#undef MASK
}
#undef KSWZ
#undef SBAR
}


namespace scn {
using bf16x8 = __attribute__((ext_vector_type(8))) short;
using f32x4  = __attribute__((ext_vector_type(4))) float;
using f32x2  = __attribute__((ext_vector_type(2))) float;
using u32x4  = __attribute__((ext_vector_type(4))) unsigned;
using u32x2  = __attribute__((ext_vector_type(2))) unsigned;
using f16x2  = __attribute__((ext_vector_type(2))) _Float16;
constexpr int CH = 32, NCHUNK = 72, NCTXCH = 8;
constexpr float DCLAMP = -115.41560327111707f;
constexpr int QK_STRIDE = 272, T_STRIDE = 80;
constexpr int QS = 0, KS = QS + CH * QK_STRIDE, KT = KS + CH * QK_STRIDE, VT = KT + 128 * T_STRIDE, BUF_BYTES = VT + 128 * T_STRIDE;
constexpr int PS0 = 3 * BUF_BYTES, PS_BYTES = CH * T_STRIDE, TT0 = PS0 + 2 * PS_BYTES, TT_BYTES = 8 * 128 * 4, SC0 = TT0 + 2 * TT_BYTES, SC_BYTES = 512, SCAN_LDS = SC0 + 4 * SC_BYTES;
constexpr int OS0 = 135168, OS1 = 147456, OS_STRIDE = 272, OS_BYTES = CH * OS_STRIDE, SCAN_LDS_TOP = OS1 + OS_BYTES;
static_assert(SCAN_LDS <= 131072 && (BUF_BYTES % 16) == 0 && (KT % 16) == 0 && (VT % 16) == 0 && (PS0 % 16) == 0 && (PS_BYTES % 16) == 0 && (TT0 % 16) == 0 && (SC0 % 16) == 0, "scan LDS");
__device__ __forceinline__ unsigned cvtpk(float lo, float hi) { unsigned r; asm volatile("v_cvt_pk_bf16_f32 %0, %1, %2" : "=v"(r) : "v"(lo), "v"(hi)); return r; }
__device__ __forceinline__ float bflo(unsigned w) { return __uint_as_float(w << 16); }
__device__ __forceinline__ float bfhi(unsigned w) { return __uint_as_float(w & 0xffff0000u); }

__device__ __forceinline__ int tok_row(int b, int dir, int ci, int tt) {
    if (ci < NCTXCH) { const int n = ci * CH + tt; return 16384 + b * 256 + (dir ? 255 - n : n); }
    const int n = (ci - NCTXCH) * CH + tt; return b * 2048 + (dir ? 2047 - n : n);
}
struct ScanCtx { const unsigned short* RQ; const unsigned short* RV; const _Float16* LFd; unsigned short* OUT; int b, h, dir, w; unsigned col2; unsigned so[4]; };
struct ChunkIn { unsigned lfr[4]; unsigned qv[4], vv[4]; float cA[4], cB[4]; };

__device__ __forceinline__ void scan_load(ChunkIn& I, const ScanCtx& C, int ci) {
#pragma unroll
    for (int i = 0; i < 4; ++i) { const size_t rb = (size_t)tok_row(C.b, C.dir, ci, 4 * C.w + i) * 2048 + C.h * 128;
        I.lfr[i] = *(const unsigned*)(C.LFd + rb + C.col2); I.qv[i] = *(const unsigned*)(C.RQ + rb + C.col2); I.vv[i] = *(const unsigned*)(C.RV + rb + C.col2); }
}
__device__ __forceinline__ void scan_cum(ChunkIn& I, char* lds, int ci, int w, int k2) {
    float sA = 0.f, sB = 0.f;
#pragma unroll
    for (int i = 0; i < 4; ++i) { const f16x2 l2 = __builtin_bit_cast(f16x2, I.lfr[i]); sA += (float)l2.x; sB += (float)l2.y; I.cA[i] = sA; I.cB[i] = sB; }
    *(f32x2*)(lds + TT0 + (ci & 1) * TT_BYTES + (w * 128 + 2 * k2) * 4) = (f32x2){sA, sB};
}
__device__ __forceinline__ void scan_prep(const ChunkIn& I, char* lds, int bo, int ci, int w, int k2) {
    float offA = 0.f, offB = 0.f, totA = 0.f, totB = 0.f;
#pragma unroll
    for (int s = 0; s < 8; ++s) { const f32x2 t = *(const f32x2*)(lds + TT0 + (ci & 1) * TT_BYTES + (s * 128 + 2 * k2) * 4);
        const float ms = (s < w) ? 1.0f : 0.0f;
        offA = fmaf(t.x, ms, offA); offB = fmaf(t.y, ms, offB); totA += t.x; totB += t.y; }
    unsigned qt[4], kt[4]; float kA_[4], kB_[4];
#pragma unroll
    for (int i = 0; i < 4; ++i) {
        const float dA = fmaxf(offA + I.cA[i], DCLAMP), dB = fmaxf(offB + I.cB[i], DCLAMP);
        const float eA = __builtin_amdgcn_exp2f(dA), eB = __builtin_amdgcn_exp2f(dB), ieA = __builtin_amdgcn_exp2f(-dA), ieB = __builtin_amdgcn_exp2f(-dB);
        const f16x2 l2 = __builtin_bit_cast(f16x2, I.lfr[i]);
        const float kkA = 1.0f - __builtin_amdgcn_exp2f((float)l2.x), kkB = 1.0f - __builtin_amdgcn_exp2f((float)l2.y);
        const float qA = bflo(I.qv[i]) * eA, qB = bfhi(I.qv[i]) * eB; kA_[i] = kkA * ieA; kB_[i] = kkB * ieB;
        qt[i] = cvtpk(qA, qB); kt[i] = cvtpk(kA_[i], kB_[i]);
    }
    char* B = lds + bo;
#pragma unroll
    for (int i = 0; i < 4; ++i) { *(unsigned*)(B + QS + (4 * w + i) * QK_STRIDE + 4 * k2) = qt[i]; *(unsigned*)(B + KS + (4 * w + i) * QK_STRIDE + 4 * k2) = kt[i]; }
    *(u32x2*)(B + KT + (2 * k2) * T_STRIDE + 8 * w) = (u32x2){cvtpk(kA_[0], kA_[1]), cvtpk(kA_[2], kA_[3])};
    *(u32x2*)(B + KT + (2 * k2 + 1) * T_STRIDE + 8 * w) = (u32x2){cvtpk(kB_[0], kB_[1]), cvtpk(kB_[2], kB_[3])};
    *(u32x2*)(B + VT + (2 * k2) * T_STRIDE + 8 * w) = (u32x2){(I.vv[0] & 0xffffu) | (I.vv[1] << 16), (I.vv[2] & 0xffffu) | (I.vv[3] << 16)};
    *(u32x2*)(B + VT + (2 * k2 + 1) * T_STRIDE + 8 * w) = (u32x2){(I.vv[0] >> 16) | (I.vv[1] & 0xffff0000u), (I.vv[2] >> 16) | (I.vv[3] & 0xffff0000u)};
    if (w == 0) *(f32x2*)(lds + SC0 + (ci & 3) * SC_BYTES + 8 * k2) = (f32x2){__builtin_amdgcn_exp2f(fmaxf(totA, DCLAMP)), __builtin_amdgcn_exp2f(fmaxf(totB, DCLAMP))};
}
__device__ __forceinline__ void scan_ptile(char* lds, int bo, int pso, int w, int l15, int q4) {
    if (w < 4) { const char* B = lds + bo; const int sb = w >> 1, tb = w & 1; f32x4 p = (f32x4){0.f, 0.f, 0.f, 0.f};
        if (sb <= tb) {
#pragma unroll
            for (int ks = 0; ks < 4; ++ks) { const bf16x8 a = *(const bf16x8*)(B + KS + (16 * sb + l15) * QK_STRIDE + 64 * ks + 16 * q4);
                const bf16x8 bq = *(const bf16x8*)(B + QS + (16 * tb + l15) * QK_STRIDE + 64 * ks + 16 * q4);
                p = __builtin_amdgcn_mfma_f32_16x16x32_bf16(a, bq, p, 0, 0, 0); }
            const int t = 16 * tb + l15, s0 = 16 * sb + 4 * q4;
#pragma unroll
            for (int r = 0; r < 4; ++r) p[r] = (s0 + r <= t) ? p[r] : 0.f;
        }
        *(u32x2*)(lds + pso + (16 * tb + l15) * T_STRIDE + (16 * sb + 4 * q4) * 2) = (u32x2){cvtpk(p[0], p[1]), cvtpk(p[2], p[3])}; }
}
template <int MODE = 15> __device__ __forceinline__ void scan_main(f32x4 (&acc)[8], char* lds, int bo, int pso, int sco, const ScanCtx& C, int ci, int w, int l15, int q4) {
    const char* B = lds + bo;
#pragma unroll
    for (int kt = 0; kt < 8; ++kt) acc[kt] = acc[kt] * *(const f32x4*)(lds + sco + (16 * kt + 4 * q4) * 4);
    f32x4 o[2];
#pragma unroll
    for (int tt = 0; tt < 2; ++tt) o[tt] = (f32x4){0.f, 0.f, 0.f, 0.f};
#pragma unroll
    for (int j = 0; j < 4; ++j) {
        const u32x4 bw = (u32x4){cvtpk(acc[2 * j][0], acc[2 * j][1]), cvtpk(acc[2 * j][2], acc[2 * j][3]), cvtpk(acc[2 * j + 1][0], acc[2 * j + 1][1]), cvtpk(acc[2 * j + 1][2], acc[2 * j + 1][3])};
        const bf16x8 bs = __builtin_bit_cast(bf16x8, bw);
#pragma unroll
        for (int tt = 0; tt < 2; ++tt) { const char* row = B + QS + (16 * tt + l15) * QK_STRIDE + (32 * j + 4 * q4) * 2;
            const u32x2 a0 = *(const u32x2*)row, a1 = *(const u32x2*)(row + 32);
            const u32x4 aw = (u32x4){a0.x, a0.y, a1.x, a1.y};
            o[tt] = __builtin_amdgcn_mfma_f32_16x16x32_bf16(__builtin_bit_cast(bf16x8, aw), bs, o[tt], 0, 0, 0); }
    }
    const bf16x8 bv = *(const bf16x8*)(B + VT + (16 * w + l15) * T_STRIDE + 16 * q4);
#pragma unroll
    for (int tt = 0; tt < 2; ++tt) { const bf16x8 ap = *(const bf16x8*)(lds + pso + (16 * tt + l15) * T_STRIDE + 16 * q4);
        o[tt] = __builtin_amdgcn_mfma_f32_16x16x32_bf16(ap, bv, o[tt], 0, 0, 0); }
#pragma unroll
    for (int kt = 0; kt < 8; ++kt) { const bf16x8 ak = *(const bf16x8*)(B + KT + (16 * kt + l15) * T_STRIDE + 16 * q4);
        acc[kt] = __builtin_amdgcn_mfma_f32_16x16x32_bf16(ak, bv, acc[kt], 0, 0, 0); }
    char* os = lds + ((ci & 1) ? OS1 : OS0);
#pragma unroll
    for (int tt = 0; tt < 2; ++tt)
#pragma unroll
        for (int r = 0; r < 4; ++r) *(unsigned short*)(os + (16 * tt + 4 * q4 + r) * OS_STRIDE + (16 * w + l15) * 2) = (unsigned short)(cvtpk(o[tt][r], 0.f) & 0xffffu);
}
__device__ __forceinline__ void scan_flush(char* lds, const ScanCtx& C, int ci, int tid) {
    const int t = tid >> 4, pc = tid & 15;
    const u32x4 v = *(const u32x4*)(lds + ((ci & 1) ? OS1 : OS0) + t * OS_STRIDE + pc * 16);
    const int row0 = tok_row(C.b, C.dir, ci, 0), row = C.dir ? row0 - t : row0 + t;
    *(u32x4*)(C.OUT + (size_t)row * 2048 + C.h * 128 + pc * 8) = v;
}
template <int MODE = 15> __device__ __forceinline__ void scan_seq(const unsigned short* __restrict__ RQ, const unsigned short* __restrict__ RV, const _Float16* __restrict__ LFd, unsigned short* __restrict__ OUT,
                                         int b, int h, int dir, char* lds) {
    int tid_o = threadIdx.x; asm volatile("" : "+v"(tid_o));
    const int tid = tid_o, w = __builtin_amdgcn_readfirstlane(tid >> 6), lane = tid & 63, l15 = lane & 15, q4 = lane >> 4;
    const int k2 = lane;
    ScanCtx C{RQ, RV, LFd, OUT, b, h, dir, w, (unsigned)(2 * k2), {0u, 0u, 0u, 0u}};
#pragma unroll
    for (int r = 0; r < 4; ++r) C.so[r] = (unsigned)((dir ? 15 - (4 * q4 + r) : 4 * q4 + r) * 2048 + l15);
    f32x4 acc[8];
#pragma unroll
    for (int i = 0; i < 8; ++i) acc[i] = (f32x4){0.f, 0.f, 0.f, 0.f};
    if (tid < 128) ((float*)(lds + SC0 + 3 * SC_BYTES))[tid] = 1.0f;
    ChunkIn IA, IB, IC;
    scan_load(IA, C, 0); scan_load(IB, C, 1); scan_load(IC, C, 2);
    scan_cum(IA, lds, 0, w, k2); scan_cum(IB, lds, 1, w, k2); __syncthreads();
    scan_prep(IA, lds, 0, 0, w, k2); scan_prep(IB, lds, BUF_BYTES, 1, w, k2); scan_load(IA, C, 3); scan_load(IB, C, 4); __syncthreads();
    scan_cum(IC, lds, 2, w, k2); scan_ptile(lds, 0, PS0, w, l15, q4); __syncthreads();
#define SCN_PSO(c) (PS0 + ((c) & 1) * PS_BYTES)
#define SCN_SCO(c) (SC0 + (((c) + 3) & 3) * SC_BYTES)
    for (int cp = 0; cp < NCHUNK; cp += 3) {
        if (cp > 0) scan_flush(lds, C, cp - 1, tid);
        if (cp + 3 < NCHUNK) if constexpr (MODE & 4) scan_cum(IA, lds, cp + 3, w, k2);
        if constexpr (MODE & 4) scan_prep(IC, lds, 2 * BUF_BYTES, cp + 2, w, k2); if (cp + 5 < NCHUNK) scan_load(IC, C, cp + 5);
        if constexpr (MODE & 8) scan_ptile(lds, BUF_BYTES, SCN_PSO(cp + 1), w, l15, q4);
        if constexpr (MODE & 2) scan_main<MODE>(acc, lds, 0, SCN_PSO(cp), SCN_SCO(cp), C, cp, w, l15, q4); __syncthreads();
        scan_flush(lds, C, cp, tid);
        if (cp + 4 < NCHUNK) if constexpr (MODE & 4) scan_cum(IB, lds, cp + 4, w, k2);
        if (cp + 3 < NCHUNK) { if constexpr (MODE & 4) scan_prep(IA, lds, 0, cp + 3, w, k2); if (cp + 6 < NCHUNK) scan_load(IA, C, cp + 6); }
        if constexpr (MODE & 8) scan_ptile(lds, 2 * BUF_BYTES, SCN_PSO(cp + 2), w, l15, q4);
        if constexpr (MODE & 2) scan_main<MODE>(acc, lds, BUF_BYTES, SCN_PSO(cp + 1), SCN_SCO(cp + 1), C, cp + 1, w, l15, q4); __syncthreads();
        scan_flush(lds, C, cp + 1, tid);
        if (cp + 5 < NCHUNK) if constexpr (MODE & 4) scan_cum(IC, lds, cp + 5, w, k2);
        if (cp + 4 < NCHUNK) { if constexpr (MODE & 4) scan_prep(IB, lds, BUF_BYTES, cp + 4, w, k2); if (cp + 7 < NCHUNK) scan_load(IB, C, cp + 7); }
        if (cp + 3 < NCHUNK) if constexpr (MODE & 8) scan_ptile(lds, 0, SCN_PSO(cp + 3), w, l15, q4);
        if constexpr (MODE & 2) scan_main<MODE>(acc, lds, 2 * BUF_BYTES, SCN_PSO(cp + 2), SCN_SCO(cp + 2), C, cp + 2, w, l15, q4); __syncthreads();
    }
    scan_flush(lds, C, NCHUNK - 1, tid);
#undef SCN_PSO
#undef SCN_SCO
}
}


constexpr int NWAVES = 8;
constexpr int DM = 2048, NBATCH = 8, SEQ = 2048, CTXL = 256, DEPTH = 4;
constexpr int ML = NBATCH * SEQ, MC = NBATCH * CTXL, MT = ML + MC;
constexpr int NQKV = 3072, NREC = 10240, DFF = 8192, NMOD = 12288;
constexpr float NORM_EPS = 1e-6f;
constexpr int N_PHASES = 3 + 8 * DEPTH;

constexpr size_t MiB = 1u << 20;
constexpr size_t WS_CTL = 0, CTL_ZERO_BYTES = 1 * MiB;
constexpr size_t WS_MOD = 1 * MiB;
constexpr size_t WS_TAB = 4 * MiB;
constexpr size_t TAB_COS = 0, TAB_SIN = 8192, TAB_LB = 16384;
constexpr size_t WS_WQKV = 8 * MiB, WS_WAO = 32 * MiB, WS_WRI = 48 * MiB, WS_WRO = 128 * MiB, WS_WUP = 144 * MiB, WS_WDN = 272 * MiB;
constexpr size_t WS_X = 400 * MiB;
constexpr size_t WS_H = 544 * MiB;
constexpr size_t WS_O = 616 * MiB;
constexpr size_t WS_U = 688 * MiB;
constexpr size_t WS_OF = WS_U, WS_OB = WS_U + 72 * MiB;
constexpr size_t WS_GSLAB = WS_U + 144 * MiB;
constexpr size_t WS_MIX = 976 * MiB;
constexpr size_t WS_RQ = WS_MIX, WS_RV = WS_MIX + 72 * MiB, WS_RG = WS_MIX + 144 * MiB, WS_LF = WS_MIX + 216 * MiB;
constexpr size_t WS_END = WS_MIX + 504 * MiB;
constexpr int CW_TMO = 0, CW_BAR = 4096;

constexpr int RING_BYTES = 131072, LDSCTL_OFF = RING_BYTES, MISC_OFF = LDSCTL_OFF + 320, LDS_BYTES = 156672;

__device__ __forceinline__ float xor_get(float v, int lane, int o) { return __int_as_float(__builtin_amdgcn_ds_bpermute((lane ^ o) << 2, __float_as_int(v))); }
__device__ __forceinline__ float wave_sum(float v, int lane) {
#pragma unroll
    for (int o = 1; o < 64; o <<= 1) v += xor_get(v, lane, o);
    return v;
}

__device__ __forceinline__ int rope_row(int n) {
    if (n >= 2560) return n;
    const int d = n & 127, a = d >> 6, jj = (d >> 5) & 1, i = d & 31;
    return (n & ~127) + a * 64 + (i >> 2) * 8 + jj * 4 + (i & 3);
}
__device__ __forceinline__ void transpose_item(const float* W, int K, int N, bf16* WT, bool perm, LAS float* scr, int item, int lane) {
    const int nblk = N / 32, kb = item / nblk, nb = item % nblk, k0 = 64 * kb, n0 = 32 * nb;
    const float* src = W + (size_t)(k0 + (lane >> 5)) * N + n0 + (lane & 31);
    float v[32];
#pragma unroll
    for (int i = 0; i < 32; ++i) v[i] = src[(size_t)(2 * i) * N];
#pragma unroll
    for (int i = 0; i < 32; ++i) scr[(2 * i + (lane >> 5)) * 33 + (lane & 31)] = v[i];
    LDS_WAIT(); asm volatile("" ::: "memory");
    const int c = lane & 7;
#pragma unroll
    for (int j = 0; j < 4; ++j) { const int n = (lane >> 3) + 8 * j; const LAS float* s = scr + (8 * c) * 33 + n;
        v4u o; o.x = pk2(s[0 * 33], s[1 * 33]); o.y = pk2(s[2 * 33], s[3 * 33]); o.z = pk2(s[4 * 33], s[5 * 33]); o.w = pk2(s[6 * 33], s[7 * 33]);
        const int row = perm ? rope_row(n0 + n) : (n0 + n);
        *(GAS v4u*)(WT + (size_t)row * K + k0 + 8 * c) = o; }
    LDS_WAIT(); asm volatile("" ::: "memory");
}

struct KArgs { const float* in[18]; float* out; unsigned char* ws; int ph_lo, ph_hi; };

__device__ __forceinline__ unsigned long long ld_u64(volatile LAS unsigned* PT, int idx);
__device__ __forceinline__ void p0_prologue(volatile LAS unsigned* PT, LAS unsigned char* lds, int tid, int lane, int wave, int gw, int NGW) {
    unsigned char* ws = (unsigned char*)(GAS unsigned char*)ld_u64(PT, 19);
    LAS float* sc = (LAS float*)lds;
    for (int i = tid; i < 9 * DM; i += NWAVES * 64) { const float x = i < 8 * DM ? ((const float*)(const GAS float*)ld_u64(PT, 1))[i] : ((const float*)(const GAS float*)ld_u64(PT, 3))[i - 8 * DM]; sc[i] = x / (1.0f + __expf(-x)); }
    __syncthreads();
    { float* PART = (float*)(ws + WS_U);
      for (int tk = gw; tk < DEPTH * 48 * 16; tk += NGW) {
          const int i = tk / 768, rem = tk % 768, cg = rem >> 4, ks = rem & 15, col = cg * 256 + 4 * lane;
          const float* W = ((const float*)(const GAS float*)ld_u64(PT, 4)) + (size_t)i * DM * NMOD + (size_t)(ks * 128) * NMOD + col;
          f32x4 acc[9];
#pragma unroll
          for (int r = 0; r < 9; ++r) acc[r] = (f32x4){0.f, 0.f, 0.f, 0.f};
#pragma unroll 2
          for (int k4 = 0; k4 < 32; ++k4) {
              const f32x4 w0 = *(const f32x4*)(W + (size_t)(4 * k4 + 0) * NMOD), w1 = *(const f32x4*)(W + (size_t)(4 * k4 + 1) * NMOD),
                          w2 = *(const f32x4*)(W + (size_t)(4 * k4 + 2) * NMOD), w3 = *(const f32x4*)(W + (size_t)(4 * k4 + 3) * NMOD);
#pragma unroll
              for (int r = 0; r < 9; ++r) { const f32x4 s4 = *(const LAS f32x4*)(sc + r * DM + ks * 128 + 4 * k4);
                  acc[r] = acc[r] + w0 * s4.x + w1 * s4.y + w2 * s4.z + w3 * s4.w; }
          }
#pragma unroll
          for (int r = 0; r < 9; ++r) *(f32x4*)(PART + (((size_t)ks * DEPTH + i) * 9 + r) * NMOD + col) = acc[r];
      } }
    if (blockIdx.x == 0) {
        float* cosT = (float*)(ws + WS_TAB + TAB_COS); float* sinT = (float*)(ws + WS_TAB + TAB_SIN); float* LB = (float*)(ws + WS_TAB + TAB_LB);
        for (int i = tid; i < 64 * 32; i += NWAVES * 64) { const int pos = i >> 5, f = i & 31; const float inv = powf(10000.0f, -(float)f / 32.0f); const float ang = (float)pos * inv;
            float sv, cv; sincosf(ang, &sv, &cv); cosT[i] = cv; sinT[i] = sv; }
        for (int i = tid; i < 2 * DM; i += NWAVES * 64) { const float l0 = ((const float*)(const GAS float*)ld_u64(PT, 13))[i], l1 = ((const float*)(const GAS float*)ld_u64(PT, 13))[2 * DM + i]; const float mx = fmaxf(l0, l1);
            const float e0 = expf(l0 - mx), e1 = expf(l1 - mx), g0 = e0 / (e0 + e1), g1 = e1 / (e0 + e1);
            LB[i] = g0 - g0; LB[2 * DM + i] = (g0 + g1) - g0; }
    }
    __syncthreads();
    LAS float* scr = (LAS float*)(lds + wave * 8448);
    constexpr int I_QKV = (DM / 64) * (NQKV / 32), I_WO = (DM / 64) * (DM / 32), I_UP = (DM / 64) * (DFF / 32), I_DN = (DFF / 64) * (DM / 32);
    constexpr int T0 = 2 * I_QKV, T1 = T0 + 2 * I_WO, T3 = T1, T4 = T3 + 4 * I_UP, T5 = T4 + 4 * I_DN;
    for (int it = gw; it < T5; it += NGW) {
        if (it < T0) { const int l = it / I_QKV, r = it % I_QKV; transpose_item(((const float*)(const GAS float*)ld_u64(PT, 8)) + (size_t)l * DM * NQKV, DM, NQKV, (bf16*)(ws + WS_WQKV) + (size_t)l * NQKV * DM, true, scr, r, lane); }
        else if (it < T1) { const int q = it - T0, l = q / I_WO, r = q % I_WO; transpose_item(((const float*)(const GAS float*)ld_u64(PT, 9)) + (size_t)l * DM * DM, DM, DM, (bf16*)(ws + WS_WAO) + (size_t)l * DM * DM, false, scr, r, lane); }
        else if (it < T4) { const int q = it - T3, l = q / I_UP, r = q % I_UP; transpose_item(((const float*)(const GAS float*)ld_u64(PT, 15)) + (size_t)l * DM * DFF, DM, DFF, (bf16*)(ws + WS_WUP) + (size_t)l * DFF * DM, false, scr, r, lane); }
        else { const int q = it - T4, l = q / I_DN, r = q % I_DN; transpose_item(((const float*)(const GAS float*)ld_u64(PT, 16)) + (size_t)l * DFF * DM, DFF, DM, (bf16*)(ws + WS_WDN) + (size_t)l * DM * DFF, false, scr, r, lane); }
    }
}


__device__ __forceinline__ void mod_reduce_phase(const float* PART, const float* bias, float* MOD, int tid, int bx, int G) {
    constexpr int TOT4 = DEPTH * 9 * NMOD / 4;
    for (int e = bx * (NWAVES * 64) + tid; e < TOT4; e += G * NWAVES * 64) {
        const int i = e / (9 * NMOD / 4), n4 = e % (NMOD / 4);
        f32x4 s = *(const f32x4*)(bias + (size_t)i * NMOD + 4 * n4);
#pragma unroll
        for (int ks = 0; ks < 16; ++ks) s = s + *(const GAS f32x4*)(PART + (size_t)ks * (DEPTH * 9 * NMOD) + 4 * (size_t)e);
        *(GAS f32x4*)(MOD + 4 * (size_t)e) = s;
    }
}
typedef _Float16 f16;
typedef _Float16 f16x8 __attribute__((ext_vector_type(8)));
__device__ __forceinline__ void norm_tail(const float (&v)[4][8], float ss, bf16* Hrow, const float* g, const float* sh, const float* scl, int lane) {
    const float rstd = rsqrtf(wave_sum(ss, lane) * (1.0f / DM) + NORM_EPS);
#pragma unroll
    for (int j = 0; j < 4; ++j) { const int c = 8 * (lane + 64 * j); v4u o;
#pragma unroll
        for (int hh = 0; hh < 2; ++hh) { const f32x4 gg = *(const f32x4*)(g + c + 4 * hh), s1 = *(const f32x4*)(scl + c + 4 * hh), s0 = *(const f32x4*)(sh + c + 4 * hh);
            const f32x4 x4 = (f32x4){v[j][4 * hh], v[j][4 * hh + 1], v[j][4 * hh + 2], v[j][4 * hh + 3]};
            const f32x4 y = ((x4 * rstd) * gg) * (s1 + 1.0f) + s0;
            if (hh == 0) { o.x = pk2(y.x, y.y); o.y = pk2(y.z, y.w); } else { o.z = pk2(y.x, y.y); o.w = pk2(y.z, y.w); } }
        *(GAS v4u*)(Hrow + c) = o; }
}
__device__ __forceinline__ void norm0_phase(const float* xl, const float* xc, f16* X, bf16* H, const float* g, const float* mod_i, int lane, int gw, int NGW) {
    for (int r = gw; r < MT; r += NGW) {
        const float* xr = r < ML ? xl + (size_t)r * DM : xc + (size_t)(r - ML) * DM;
        const int r9 = r < ML ? (r >> 11) : 8;
        const float* sh = mod_i + (size_t)r9 * NMOD; const float* scl = sh + DM;
        float v[4][8]; float ss = 0.f;
#pragma unroll
        for (int j = 0; j < 4; ++j) { const int c = 8 * (lane + 64 * j); const f32x4 a = *(const GAS f32x4*)(xr + c), b = *(const GAS f32x4*)(xr + c + 4); f16x8 h;
#pragma unroll
            for (int e = 0; e < 4; ++e) { v[j][e] = a[e]; v[j][4 + e] = b[e]; h[e] = (f16)a[e]; h[4 + e] = (f16)b[e]; }
            *(GAS f16x8*)(X + (size_t)r * DM + c) = h;
#pragma unroll
            for (int e = 0; e < 8; ++e) ss += v[j][e] * v[j][e]; }
        norm_tail(v, ss, H + (size_t)r * DM, g, sh, scl, lane);
    }
}
__device__ __forceinline__ void norm_phase(f16* X, bf16* H, const float* g, const float* mod_i, int shift_chunk, int nrows, int lane, int gw, int NGW,
                                           const f16* slab = nullptr, const float* gate_ctx = nullptr) {
    for (int r = gw; r < nrows; r += NGW) {
        f16* xr = X + (size_t)r * DM;
        const int r9 = r < ML ? (r >> 11) : 8;
        const float* sh = mod_i + (size_t)r9 * NMOD + shift_chunk * DM; const float* scl = sh + DM;
        float v[4][8]; float ss = 0.f;
        const bool fold = (slab != nullptr) && (r >= ML);
#pragma unroll
        for (int j = 0; j < 4; ++j) { const int c = 8 * (lane + 64 * j); const f16x8 xv = *(const GAS f16x8*)(xr + c);
#pragma unroll
            for (int e = 0; e < 8; ++e) v[j][e] = (float)xv[e];
            if (fold) { constexpr size_t PS_ = (size_t)MC * DM; f16x8 h;
                const size_t po = (size_t)(r - ML) * DM + c;
                const f16x8 p0 = *(const GAS f16x8*)(slab + po), p1 = *(const GAS f16x8*)(slab + PS_ + po), p2 = *(const GAS f16x8*)(slab + 2 * PS_ + po), p3 = *(const GAS f16x8*)(slab + 3 * PS_ + po);
                const f32x4 gc0 = *(const f32x4*)(gate_ctx + c), gc1 = *(const f32x4*)(gate_ctx + c + 4);
#pragma unroll
                for (int e = 0; e < 8; ++e) { const float p = (((float)p0[e] + (float)p1[e]) + (float)p2[e]) + (float)p3[e]; v[j][e] += (e < 4 ? gc0[e & 3] : gc1[e & 3]) * p; h[e] = (f16)v[j][e]; }
                *(GAS f16x8*)(xr + c) = h; }
#pragma unroll
            for (int e = 0; e < 8; ++e) ss += v[j][e] * v[j][e]; }
        norm_tail(v, ss, H + (size_t)r * DM, g, sh, scl, lane);
    }
}
__device__ __forceinline__ void readout_phase(const bf16* OF, const bf16* OB, const bf16* RG, const f16* gslab, const float* og, bf16* O, int nrows, int lane, int gw, int NGW) {
    const f32x4 g4 = *(const f32x4*)(og + ((4 * lane) & 127));
    typedef _Float16 f16x4 __attribute__((ext_vector_type(4)));
    for (int r = gw; r < nrows; r += NGW) {
#pragma unroll
        for (int j = 0; j < 8; ++j) { const size_t off = (size_t)r * DM + 4 * (lane + 64 * j);
            const unsigned long long f8 = *(const GAS unsigned long long*)(OF + off), b8 = *(const GAS unsigned long long*)(OB + off);
            f32x4 gr;
            if (r < ML) { const unsigned long long gw8 = *(const GAS unsigned long long*)(RG + off); const unsigned glo = (unsigned)gw8, ghi = (unsigned)(gw8 >> 32);
                gr = (f32x4){__uint_as_float(glo << 16), __uint_as_float(glo & 0xffff0000u), __uint_as_float(ghi << 16), __uint_as_float(ghi & 0xffff0000u)}; }
            else { const size_t po = (size_t)(r - ML) * DM + 4 * (lane + 64 * j); constexpr size_t PS_ = (size_t)MC * DM;
                const f16x4 p0 = *(const GAS f16x4*)(gslab + po), p1 = *(const GAS f16x4*)(gslab + PS_ + po), p2 = *(const GAS f16x4*)(gslab + 2 * PS_ + po), p3 = *(const GAS f16x4*)(gslab + 3 * PS_ + po);
#pragma unroll
                for (int e = 0; e < 4; ++e) gr[e] = (((float)p0[e] + (float)p1[e]) + (float)p2[e]) + (float)p3[e]; }
            const unsigned flo = (unsigned)f8, fhi = (unsigned)(f8 >> 32), blo = (unsigned)b8, bhi = (unsigned)(b8 >> 32);
            f32x4 s; s.x = __uint_as_float(flo << 16) + __uint_as_float(blo << 16); s.y = __uint_as_float(flo & 0xffff0000u) + __uint_as_float(blo & 0xffff0000u);
            s.z = __uint_as_float(fhi << 16) + __uint_as_float(bhi << 16); s.w = __uint_as_float(fhi & 0xffff0000u) + __uint_as_float(bhi & 0xffff0000u);
            float ss = (s.x * s.x + s.y * s.y) + (s.z * s.z + s.w * s.w);
#pragma unroll
            for (int o = 1; o < 32; o <<= 1) ss += xor_get(ss, lane, o);
            const float rstd = rsqrtf(ss * (1.0f / 128.0f) + NORM_EPS);
#pragma unroll
            for (int e = 0; e < 4; ++e) gr[e] = gr[e] * __builtin_amdgcn_rcpf(1.0f + __expf(-gr[e]));
            const float y0 = (s.x * rstd) * g4.x * gr.x, y1 = (s.y * rstd) * g4.y * gr.y, y2 = (s.z * rstd) * g4.z * gr.z, y3 = (s.w * rstd) * g4.w * gr.w;
            *(GAS unsigned long long*)(O + off) = (unsigned long long)pk2(y0, y1) | ((unsigned long long)pk2(y2, y3) << 32); }
    }
}
__device__ __forceinline__ void final_norm_phase(const f16* X, const float* g, float* out, int lane, int gw, int NGW) {
    for (int r = gw; r < ML; r += NGW) {
        float v[4][8]; float ss = 0.f;
#pragma unroll
        for (int j = 0; j < 4; ++j) { const f16x8 xv = *(const GAS f16x8*)(X + (size_t)r * DM + 8 * (lane + 64 * j));
#pragma unroll
            for (int e = 0; e < 8; ++e) { v[j][e] = (float)xv[e]; ss += v[j][e] * v[j][e]; } }
        const float rstd = rsqrtf(wave_sum(ss, lane) * (1.0f / DM) + NORM_EPS);
#pragma unroll
        for (int j = 0; j < 4; ++j) { const int c = 8 * (lane + 64 * j);
#pragma unroll
            for (int hh = 0; hh < 2; ++hh) { const f32x4 gg = *(const f32x4*)(g + c + 4 * hh);
                *(GAS f32x4*)(out + (size_t)r * DM + c + 4 * hh) = ((f32x4){v[j][4 * hh], v[j][4 * hh + 1], v[j][4 * hh + 2], v[j][4 * hh + 3]} * rstd) * gg; } }
    }
}

__device__ __forceinline__ unsigned long long ld_u64(volatile LAS unsigned* PT, int idx) {
    const unsigned lo = __builtin_amdgcn_readfirstlane(PT[2 * idx]), hi = __builtin_amdgcn_readfirstlane(PT[2 * idx + 1]);
    return ((unsigned long long)hi << 32) | lo;
}
#define PIN(i) ((const float*)(const GAS float*)ld_u64(PT, (i)))
#define PWS() ((unsigned char*)(GAS unsigned char*)ld_u64(PT, 19))
__global__ void __launch_bounds__(NWAVES * 64, 2) mk_fwd(KArgs args) {
    extern __shared__ __attribute__((aligned(16))) unsigned char lds[];
    LAS unsigned char* L = (LAS unsigned char*)lds;
    volatile LAS unsigned* MISC = (volatile LAS unsigned*)(L + MISC_OFF);
    volatile LAS unsigned* PT = (volatile LAS unsigned*)(L + MISC_OFF + 256);
    const int tid = threadIdx.x;
    for (int u = tid; u < (LDS_BYTES - LDSCTL_OFF) / 4; u += NWAVES * 64) ((LAS unsigned*)(L + LDSCTL_OFF))[u] = 0u;
    __syncthreads();
    if (tid == 0) {
#define PUT(i, p) do { const unsigned long long v_ = (unsigned long long)(p); PT[2 * (i)] = (unsigned)v_; PT[2 * (i) + 1] = (unsigned)(v_ >> 32); } while (0)
        PUT(0, args.in[0]); PUT(1, args.in[1]); PUT(2, args.in[2]); PUT(3, args.in[3]); PUT(4, args.in[4]); PUT(5, args.in[5]); PUT(6, args.in[6]); PUT(7, args.in[7]); PUT(8, args.in[8]);
        PUT(9, args.in[9]); PUT(10, args.in[10]); PUT(11, args.in[11]); PUT(12, args.in[12]); PUT(13, args.in[13]); PUT(14, args.in[14]); PUT(15, args.in[15]); PUT(16, args.in[16]);
        PUT(17, args.in[17]); PUT(18, args.out); PUT(19, args.ws); PT[40] = (unsigned)args.ph_lo; PT[41] = (unsigned)args.ph_hi;
#undef PUT
    }
    __syncthreads();
#define PH_LO() ((int)__builtin_amdgcn_readfirstlane(PT[40]))
#define PH_HI() ((int)__builtin_amdgcn_readfirstlane(PT[41]))
    if (PH_HI() - PH_LO() > 1) (void)xcd_barrier_post((unsigned*)((gu32*)(PWS() + WS_CTL) + CW_BAR), MISC + 8);
#define IN(k) (PH_LO() <= (k) && (k) < PH_HI())
#define SEAM(k) do { if ((k) + 1 < PH_HI()) { XcdBarrier b_; b_.bar = (unsigned*)((gu32*)(PWS() + WS_CTL) + CW_BAR); b_.x = xb_xcc_id(); b_.st = MISC + 8; xcd_barrier(b_); } } while (0)
#define GEO() int tid_g = threadIdx.x; asm volatile("" : "+v"(tid_g)); const int lane = tid_g & 63, wave = __builtin_amdgcn_readfirstlane(tid_g >> 6), G = gridDim.x, bx = blockIdx.x, \
                        vcu = (G % 8 == 0) ? (bx % 8) * (G / 8) + bx / 8 : bx, gw = vcu * NWAVES + wave, NGW = G * NWAVES; (void)lane; (void)gw; (void)NGW

    if (IN(0)) { GEO(); p0_prologue(PT, L, tid_g, lane, wave, gw, NGW); SEAM(0); }
    if (IN(1)) { GEO(); unsigned char* ws = PWS(); mod_reduce_phase((const float*)(ws + WS_U), PIN(5), (float*)(ws + WS_MOD), tid_g, bx, G); SEAM(1); }
    if (IN(2)) { GEO(); unsigned char* ws = PWS(); norm0_phase(PIN(0), PIN(2), (f16*)(ws + WS_X), (bf16*)(ws + WS_H), PIN(6), (const float*)(ws + WS_MOD), lane, gw, NGW); SEAM(2); }

    for (int Lr = 0; Lr < DEPTH; ++Lr) {
        const int pb = 3 + 8 * Lr;
        if ((Lr & 1) == 0) {
            if (IN(pb + 0)) {
                GEO(); unsigned char* ws = PWS(); const int jl = Lr >> 1;
                pg8::Gemm g{(const bf16*)(ws + WS_H), (const bf16*)(ws + WS_WQKV) + (size_t)jl * NQKV * DM, MT, NQKV, DM, DM}; pg8::StaticOrder S; S.init(MT, NQKV, G, bx);
                pg8::EpiQkv E{(bf16*)(ws + WS_MIX), (const float*)(ws + WS_TAB + TAB_COS), (const float*)(ws + WS_TAB + TAB_SIN)};
                pg8::gemm_phase<pg8::EpiQkv, pg8::StaticOrder, true, true>(L, g, S, E);
                { constexpr int NU = (MT / 256) * (NQKV / 256), I_RI = (DM / 64) * (NREC / 32), I_WO = (DM / 64) * (DM / 32);
                  const int first = NU % G, nid = G - first;
                  if (bx >= first) { LAS float* scr = (LAS float*)(L + wave * 8448);
                      for (int it = (bx - first) * NWAVES + wave; it < I_RI + I_WO; it += nid * NWAVES) {
                          if (it < I_RI) transpose_item(PIN(11) + (size_t)jl * DM * NREC, DM, NREC, (bf16*)(ws + WS_WRI) + (size_t)jl * NREC * DM, false, scr, it, lane);
                          else transpose_item(PIN(12) + (size_t)jl * DM * DM, DM, DM, (bf16*)(ws + WS_WRO) + (size_t)jl * DM * DM, false, scr, it - I_RI, lane); } } }
                SEAM(pb + 0);
            }
            if (IN(pb + 1)) {
                GEO(); unsigned char* ws = PWS(); const int jl = Lr >> 1;
                const bf16* QKV = (const bf16*)(ws + WS_MIX); bf16* Ob = (bf16*)(ws + WS_O); const float* sinkp = PIN(10) + jl * 16;
#ifndef REP_ATTN
#define REP_ATTN 1
#endif
                for (int rep_ = 0; rep_ < REP_ATTN; ++rep_) att::attn_units(QKV, Ob, sinkp, bx, G, (char*)lds);
                SEAM(pb + 1);
            }
        } else {
            if (IN(pb + 0)) {
                GEO(); unsigned char* ws = PWS(); const int jl = Lr >> 1;
                const bf16* Wri = (const bf16*)(ws + WS_WRI) + (size_t)jl * NREC * DM;
                pg8::Gemm g{(const bf16*)(ws + WS_H), Wri, MT, NREC, DM, DM}; pg8::RecOrder S; S.init(G, bx);
                pg8::EpiRec E{(bf16*)(ws + WS_RQ), (bf16*)(ws + WS_RV), (bf16*)(ws + WS_RG), (pg8::f16_t*)(ws + WS_LF), (const float*)(ws + WS_TAB + TAB_LB) + jl * 2 * DM, (size_t)MT * DM, jl == 0};
                pg8::gemm_phase<pg8::EpiRec, pg8::RecOrder, true, true>(L, g, S, E);
                if (Lr != DEPTH - 1) { pg8::Gemm g2{(const bf16*)(ws + WS_H), Wri + (size_t)(4 * DM) * DM, MT, DM, DM / 4, DM}; pg8::SplitKCtxOrder S2; S2.init(G, bx, DM / 4);
                    pg8::EpiPart E2{(pg8::f16_t*)(ws + WS_GSLAB), DM / 4};
                    pg8::gemm_phase<pg8::EpiPart, pg8::SplitKCtxOrder, true, true>(L, g2, S2, E2); }
                SEAM(pb + 0);
            }
            if (IN(pb + 1)) {
                GEO(); unsigned char* ws = PWS();
                for (int sid = bx; sid < 256; sid += G) { const int b = sid >> 5, h = (sid >> 1) & 15, dir = sid & 1;
                    scn::scan_seq<15>((const bf16*)(ws + WS_RQ), (const bf16*)(ws + WS_RV), (const f16*)(ws + WS_LF) + (size_t)dir * MT * DM, (bf16*)(ws + (dir ? WS_OB : WS_OF)), b, h, dir, (char*)lds);
                    __syncthreads();
#ifdef PROBE_MODE
                    scn::scan_seq<PROBE_MODE>((const bf16*)(ws + WS_RQ), (const bf16*)(ws + WS_RV), (const f16*)(ws + WS_LF) + (size_t)dir * MT * DM, (bf16*)(ws + (dir ? WS_OB : WS_OF)), b, h, dir, (char*)lds);
                    __syncthreads();
#endif
                }
                SEAM(pb + 1);
            }
            if (IN(pb + 2)) {
                GEO(); unsigned char* ws = PWS(); const int jl = Lr >> 1;
                readout_phase((const bf16*)(ws + WS_OF), (const bf16*)(ws + WS_OB), (const bf16*)(ws + WS_RG), (const f16*)(ws + WS_GSLAB), PIN(14) + jl * 128, (bf16*)(ws + WS_O), Lr == DEPTH - 1 ? ML : MT, lane, gw, NGW);
                SEAM(pb + 2);
            }
        }
        if (IN(pb + 3)) {
            GEO(); unsigned char* ws = PWS(); const int jl = Lr >> 1, Mrows = (Lr == DEPTH - 1) ? ML : MT;
            const bf16* Wt = (Lr & 1) ? (const bf16*)(ws + WS_WRO) + (size_t)jl * DM * DM : (const bf16*)(ws + WS_WAO) + (size_t)jl * DM * DM;
            pg8::Gemm g{(const bf16*)(ws + WS_O), Wt, ML, DM, DM, DM}; pg8::StaticOrder S; S.init(ML, DM, G, bx);
            pg8::EpiRes E{(pg8::f16_t*)(ws + WS_X), (const float*)(ws + WS_MOD) + (size_t)Lr * 9 * NMOD + 2 * DM};
            pg8::gemm_phase<pg8::EpiRes, pg8::StaticOrder, true, true>(L, g, S, E);
            if (Mrows == MT) { pg8::Gemm g2{(const bf16*)(ws + WS_O), Wt, MT, DM, DM / 4, DM}; pg8::SplitKCtxOrder S2; S2.init(G, bx, DM / 4);
                pg8::EpiPart E2{(pg8::f16_t*)(ws + WS_U), DM / 4};
                pg8::gemm_phase<pg8::EpiPart, pg8::SplitKCtxOrder, true, true>(L, g2, S2, E2); }
            SEAM(pb + 3);
        }
        if (IN(pb + 4)) { GEO(); unsigned char* ws = PWS();
            norm_phase((f16*)(ws + WS_X), (bf16*)(ws + WS_H), PIN(7) + Lr * DM, (const float*)(ws + WS_MOD) + (size_t)Lr * 9 * NMOD, 3, (Lr == DEPTH - 1) ? ML : MT, lane, gw, NGW,
                       (const f16*)(ws + WS_U), (const float*)(ws + WS_MOD) + ((size_t)Lr * 9 + 8) * NMOD + 2 * DM); SEAM(pb + 4); }
        if (IN(pb + 5)) {
            GEO(); unsigned char* ws = PWS(); const int Mrows = (Lr == DEPTH - 1) ? ML : MT;
            pg8::Gemm g{(const bf16*)(ws + WS_H), (const bf16*)(ws + WS_WUP) + (size_t)Lr * DFF * DM, Mrows, DFF, DM, DM}; pg8::StaticOrder S; S.init(Mrows, DFF, G, bx);
            pg8::EpiUp E{(bf16*)(ws + WS_U), DFF};
            pg8::gemm_phase<pg8::EpiUp, pg8::StaticOrder, true, true>(L, g, S, E);
            SEAM(pb + 5);
        }
        if (IN(pb + 6)) {
            GEO(); unsigned char* ws = PWS(); const int Mrows = (Lr == DEPTH - 1) ? ML : MT;
            const bf16* Wd = (const bf16*)(ws + WS_WDN) + (size_t)Lr * DM * DFF;
            pg8::Gemm g{(const bf16*)(ws + WS_U), Wd, ML, DM, DFF, DFF}; pg8::StaticOrder S; S.init(ML, DM, G, bx);
            pg8::EpiRes E{(pg8::f16_t*)(ws + WS_X), (const float*)(ws + WS_MOD) + (size_t)Lr * 9 * NMOD + 5 * DM};
            pg8::gemm_phase<pg8::EpiRes, pg8::StaticOrder, true, true>(L, g, S, E);
            if (Mrows == MT) { pg8::Gemm g2{(const bf16*)(ws + WS_U), Wd, MT, DM, DFF / 4, DFF}; pg8::SplitKCtxOrder S2; S2.init(G, bx, DFF / 4);
                pg8::EpiPart E2{(pg8::f16_t*)(ws + WS_O), DFF / 4};
                pg8::gemm_phase<pg8::EpiPart, pg8::SplitKCtxOrder, true, true>(L, g2, S2, E2); }
            SEAM(pb + 6);
        }
        if (IN(pb + 7)) {
            GEO(); unsigned char* ws = PWS(); f16* X = (f16*)(ws + WS_X);
            if (Lr != DEPTH - 1) norm_phase(X, (bf16*)(ws + WS_H), PIN(6) + (Lr + 1) * DM, (const float*)(ws + WS_MOD) + (size_t)(Lr + 1) * 9 * NMOD, 0, MT, lane, gw, NGW,
                                            (const f16*)(ws + WS_O), (const float*)(ws + WS_MOD) + ((size_t)Lr * 9 + 8) * NMOD + 5 * DM);
            else final_norm_phase(X, PIN(17), (float*)(GAS float*)ld_u64(PT, 18), lane, gw, NGW);
            SEAM(pb + 7);
        }
    }
#undef IN
#undef SEAM
#undef GEO
}

#ifndef MK_ONE_LAUNCH
#define MK_ONE_LAUNCH 1
#endif
extern "C" void kernel_launch(void* const* d_in, const int* in_sizes, int n_in, void* d_out, int out_size, void* d_ws, size_t ws_size, hipStream_t stream) {
    static int grid = 0;
    if (grid == 0) {
        if (n_in != 18 || in_sizes[0] != ML * DM || out_size != ML * DM || ws_size < WS_END) {
            fprintf(stderr, "kernel_launch: shape mismatch: n_in %d in0 %d out %d ws %zu (need %zu)\n", n_in, n_in > 0 ? in_sizes[0] : -1, out_size, ws_size, (size_t)WS_END); grid = -1; return; }
        int dev = 0, cus = 0, per_cu = 0;
        if (hipGetDevice(&dev) != hipSuccess || hipDeviceGetAttribute(&cus, hipDeviceAttributeMultiprocessorCount, dev) != hipSuccess) { fprintf(stderr, "kernel_launch: device query failed\n"); grid = -1; return; }
        if (hipFuncSetAttribute((const void*)mk_fwd, hipFuncAttributeMaxDynamicSharedMemorySize, LDS_BYTES) != hipSuccess) { fprintf(stderr, "kernel_launch: hipFuncSetAttribute failed\n"); grid = -1; return; }
        if (hipOccupancyMaxActiveBlocksPerMultiprocessor(&per_cu, (const void*)mk_fwd, NWAVES * 64, LDS_BYTES) != hipSuccess || per_cu < 1)
            fprintf(stderr, "kernel_launch: note: occupancy query reports %d workgroups per CU\n", per_cu);
        (void)hipGetLastError();
        grid = cus;
    }
    if (grid < 0) return;
    if (hipMemsetAsync((char*)d_ws + WS_CTL, 0, CTL_ZERO_BYTES, stream) != hipSuccess) { fprintf(stderr, "kernel_launch: memset failed\n"); return; }
    KArgs a{};
    for (int i = 0; i < 18; ++i) a.in[i] = (const float*)d_in[i];
    a.out = (float*)d_out; a.ws = (unsigned char*)d_ws;
#if MK_ONE_LAUNCH
    a.ph_lo = 0; a.ph_hi = N_PHASES;
    hipLaunchKernelGGL(mk_fwd, dim3(grid), dim3(NWAVES * 64), LDS_BYTES, stream, a);
#else
    for (int ph = 0; ph < N_PHASES; ++ph) {
        if (ph >= 3) { const int Lr = (ph - 3) / 8, s = (ph - 3) % 8; if ((Lr & 1) == 0 && s == 2) continue; }
        a.ph_lo = ph; a.ph_hi = ph + 1;
        hipLaunchKernelGGL(mk_fwd, dim3(grid), dim3(NWAVES * 64), LDS_BYTES, stream, a);
    }
#endif
    const hipError_t le = hipPeekAtLastError();
    if (le != hipSuccess) fprintf(stderr, "kernel_launch: launch failed: %s\n", hipGetErrorName(le));
}
```

```cpp
#include <hip/hip_runtime.h>
#include <cstdio>
#include <cstdint>
#include <cmath>

namespace pg8 {
#define PG8_LAS __attribute__((address_space(3)))
typedef unsigned short bf16_t;
typedef short bf16x8 __attribute__((ext_vector_type(8)));
typedef float f32x4 __attribute__((ext_vector_type(4)));
typedef unsigned u32x4 __attribute__((ext_vector_type(4)));
typedef unsigned u32x2 __attribute__((ext_vector_type(2)));
constexpr int BM = 256, BK = 64, HALF = 128, HTB = HALF * BK * 2  , STAGE_BYTES = 8 * HTB, NXCD = 8, WGM = 4;

__host__ __device__ __forceinline__ int lds_byte(int r, int c) { const int st = (r >> 4) * 2 + (c >> 5), rr = r & 15, cc = c & 31, ob = rr * 64 + cc * 2; return st * 1024 + (ob ^ (((ob >> 9) & 1) << 5)); }
__host__ __device__ __forceinline__ void stage_rc(int b, int& R, int& C) { const int st = b / 1024, sb = b % 1024, swz = sb ^ (((sb >> 9) & 1) << 5); R = (st >> 1) * 16 + swz / 64; C = (st & 1) * 32 + (swz % 64) / 2; }
__host__ __device__ __forceinline__ int perm32(int rho) { const int n = rho >> 4, i = rho & 15; return 8 * (i >> 2) + 4 * n + (i & 3); }

struct Unit { int pm, pn, kofs; };
struct Gemm { const bf16_t* A; const bf16_t* Bt; int M, N, K, ld; };


struct SplitKCtxOrder {
    int G, c, ks;
    __host__ __device__ void init(int G_, int c_, int ks_) { G = G_; c = c_; ks = ks_; }
    __host__ __device__ bool next(int i, Unit& u) const {
        const int idx = i * G + c; if (idx >= 256) return false;
        const int t = idx >> 2; u.pm = 64 + (t >> 3); u.pn = t & 7; u.kofs = (idx & 3) * ks; return true;
    }
    __device__ __forceinline__ void a_ready(const Unit&) const {}
    __device__ __forceinline__ void done(const Unit&) const {}
};
struct StaticOrder {
    int nM, nN, nwg, G, c;
    __host__ __device__ void init(int M, int N, int G_, int c_) { nM = M / BM; nN = N / BM; nwg = nM * nN; G = G_; c = c_; }
    __host__ __device__ bool next(int i, Unit& u) const { return map((long)i * G + c, u); }
    __host__ __device__ bool map(long L, Unit& u) const {
        if (L >= nwg) return false;
        int wgid = (int)L; { const int q = nwg / NXCD, r = nwg % NXCD, xcd = wgid % NXCD, off = wgid / NXCD; wgid = (xcd < r ? xcd * (q + 1) : r * (q + 1) + (xcd - r) * q) + off; }
        const int nig = WGM * nN, gid = wgid / nig, fm = gid * WGM, gsz = (nM - fm) < WGM ? (nM - fm) : WGM;
        u.pm = fm + ((wgid % nig) % gsz); u.pn = (wgid % nig) / gsz; u.kofs = 0; return true;
    }
    __device__ __forceinline__ void a_ready(const Unit&) const {}
    __device__ __forceinline__ void done(const Unit&) const {}
};
struct RecOrder {
    StaticOrder lat, ctx; int G, c;
    __host__ __device__ void init(int G_, int c_) { G = G_; c = c_; lat.init(16384, 10240, G_, c_); ctx.init(2048, 8192, G_, c_); }
    __host__ __device__ bool next(int i, Unit& u) const {
        long L = (long)i * G + c; if (L < lat.nwg) return lat.map(L, u);
        L -= lat.nwg; if (!ctx.map(L, u)) return false;
        u.pm += 64; return true;
    }
    __device__ __forceinline__ void a_ready(const Unit&) const {}
    __device__ __forceinline__ void done(const Unit&) const {}
};


__device__ __forceinline__ unsigned cvt_pk_bf16(float lo, float hi) { unsigned r; asm volatile("v_cvt_pk_bf16_f32 %0, %1, %2" : "=v"(r) : "v"(lo), "v"(hi)); return r; }
__device__ __forceinline__ float fast_sigmoid(float x) { return __builtin_amdgcn_rcpf(1.0f + __expf(-x)); }
__device__ __forceinline__ float fast_silu(float x) { return x * fast_sigmoid(x); }

constexpr int E_ML = 16384;
constexpr int E_DM = 2048, E_NMOD = 12288;

typedef _Float16 f16_t;
typedef _Float16 f16x8 __attribute__((ext_vector_type(8)));
struct EpiRes {
    static constexpr bool PERM = true, AFTER_DRAIN = false;
    f16_t* X; const float* gate;
    __device__ __forceinline__ void operator()(const f32x4 (&acc)[2][2][4][2], const Unit& u, int wr, int wc, int fr, int fq) const {
        const int row0 = u.pm * BM + wr * 64 + fr, col0 = u.pn * BM + wc * 32 + 8 * fq;
        const int r9 = (u.pm < (E_ML / BM)) ? (u.pm >> 3) : 8;
        const float* gp = gate + (size_t)r9 * E_NMOD + col0;
        f32x4 gv[2][2];
#pragma unroll
        for (int bj = 0; bj < 2; ++bj)
#pragma unroll
            for (int n = 0; n < 2; ++n) gv[bj][n] = *(const f32x4*)(gp + bj * HALF + 4 * n);
        f16_t* xp = X + (size_t)row0 * E_DM + col0;
#pragma unroll
        for (int ai = 0; ai < 2; ++ai) {
            f16x8 xv[4][2];
#pragma unroll
            for (int m = 0; m < 4; ++m)
#pragma unroll
                for (int bj = 0; bj < 2; ++bj) xv[m][bj] = *(const f16x8*)(xp + (size_t)(ai * HALF + m * 16) * E_DM + bj * HALF);
#pragma unroll
            for (int m = 0; m < 4; ++m)
#pragma unroll
                for (int bj = 0; bj < 2; ++bj) { f16x8 r;
#pragma unroll
                    for (int j = 0; j < 4; ++j) { r[j] = (f16_t)((float)xv[m][bj][j] + gv[bj][0][j] * acc[ai][bj][m][0][j]); r[4 + j] = (f16_t)((float)xv[m][bj][4 + j] + gv[bj][1][j] * acc[ai][bj][m][1][j]); }
                    *(f16x8*)(xp + (size_t)(ai * HALF + m * 16) * E_DM + bj * HALF) = r; }
            asm volatile("" ::: "memory"); }
    }
};
struct EpiUp {
    static constexpr bool PERM = true, AFTER_DRAIN = false;
    bf16_t* O; int ldc;
    __device__ __forceinline__ void operator()(const f32x4 (&acc)[2][2][4][2], const Unit& u, int wr, int wc, int fr, int fq) const {
        const int row0 = u.pm * BM + wr * 64 + fr, col0 = u.pn * BM + wc * 32 + 8 * fq;
#pragma unroll
        for (int ai = 0; ai < 2; ++ai)
#pragma unroll
            for (int m = 0; m < 4; ++m) { bf16_t* rowp = O + (size_t)(row0 + ai * HALF + m * 16) * ldc + col0;
#pragma unroll
                for (int bj = 0; bj < 2; ++bj) { f32x4 v0 = acc[ai][bj][m][0], v1 = acc[ai][bj][m][1], m0, m1;
#pragma unroll
                    for (int j = 0; j < 4; ++j) { asm("v_max_f32 %0, 0, %1" : "=v"(m0[j]) : "v"(v0[j])); asm("v_max_f32 %0, 0, %1" : "=v"(m1[j]) : "v"(v1[j])); }
                    v0 = v0 * m0; v1 = v1 * m1;
                    u32x4 w; w.x = cvt_pk_bf16(v0[0], v0[1]); w.y = cvt_pk_bf16(v0[2], v0[3]); w.z = cvt_pk_bf16(v1[0], v1[1]); w.w = cvt_pk_bf16(v1[2], v1[3]);
                    *(u32x4*)(rowp + bj * HALF) = w; } }
    }
};
struct EpiQkv {
    static constexpr bool PERM = true, AFTER_DRAIN = false;
    bf16_t* O; const float* cosT; const float* sinT;
    __device__ __forceinline__ void operator()(const f32x4 (&acc)[2][2][4][2], const Unit& u, int wr, int wc, int fr, int fq) const {
        const int row0 = u.pm * BM + wr * 64 + fr, col0 = u.pn * BM + wc * 32 + 8 * fq;
        const bool rope = (u.pn < 10) && (u.pm < (E_ML / BM));
        const int axis = wc >> 1, i0 = ((wc & 1) * 4 + fq) * 4;
#pragma unroll
        for (int ai = 0; ai < 2; ++ai)
#pragma unroll
            for (int m = 0; m < 4; ++m) { const int row = row0 + ai * HALF + m * 16; bf16_t* rowp = O + (size_t)row * 3072 + col0;
                f32x4 c4 = (f32x4){1.f, 1.f, 1.f, 1.f}, s4 = (f32x4){0.f, 0.f, 0.f, 0.f};
                if (rope) { const int t = row & 2047; const int pos = axis ? (t & 63) : (t >> 6); c4 = *(const f32x4*)(cosT + pos * 32 + i0); s4 = *(const f32x4*)(sinT + pos * 32 + i0); }
#pragma unroll
                for (int bj = 0; bj < 2; ++bj) { const f32x4 v0 = acc[ai][bj][m][0], v1 = acc[ai][bj][m][1];
                    const f32x4 o0 = v0 * c4 - v1 * s4, o1 = v1 * c4 + v0 * s4;
                    u32x4 w; w.x = cvt_pk_bf16(o0[0], o0[1]); w.y = cvt_pk_bf16(o0[2], o0[3]); w.z = cvt_pk_bf16(o1[0], o1[1]); w.w = cvt_pk_bf16(o1[2], o1[3]);
                    *(u32x4*)(rowp + bj * HALF) = w; } }
    }
};
struct EpiRec {
    static constexpr bool PERM = true, AFTER_DRAIN = false;
    bf16_t* RQ; bf16_t* RV; bf16_t* RG; f16_t* LF; const float* LB; size_t lf_stride; bool lb_zero;
    __device__ __forceinline__ void operator()(const f32x4 (&acc)[2][2][4][2], const Unit& u, int wr, int wc, int fr, int fq) const {
        const int seg = u.pn >> 3;
        const int row0 = u.pm * BM + wr * 64 + fr, col0 = (u.pn & 7) * BM + wc * 32 + 8 * fq;
        if (seg == 2 || seg == 3) {
            const int dir = seg - 2; f16_t* base = LF + (size_t)dir * lf_stride;
            f32x4 lb[2][2];
#pragma unroll
            for (int bj = 0; bj < 2; ++bj)
#pragma unroll
                for (int n = 0; n < 2; ++n) lb[bj][n] = *(const f32x4*)(LB + dir * E_DM + col0 + bj * HALF + 4 * n);
#define EPIREC_F_LOOP(EXPR) _Pragma("unroll") for (int ai = 0; ai < 2; ++ai) _Pragma("unroll") for (int m = 0; m < 4; ++m) { f16_t* rowp = base + (size_t)(row0 + ai * HALF + m * 16) * E_DM + col0; \
                _Pragma("unroll") for (int bj = 0; bj < 2; ++bj) { f16x8 o; \
                    _Pragma("unroll") for (int n = 0; n < 2; ++n) { const f32x4 z = acc[ai][bj][m][n]; \
                        _Pragma("unroll") for (int j = 0; j < 4; ++j) { const float zc = fmaxf(z[j], -80.f); const float l = lb[bj][n][j]; (void)l; o[4 * n + j] = (f16_t)(EXPR); } } \
                    *(f16x8*)(rowp + bj * HALF) = o; } }
            if (lb_zero) { EPIREC_F_LOOP(-__builtin_amdgcn_logf(1.0f + __expf(-zc))) }
            else { EPIREC_F_LOOP(__builtin_amdgcn_logf(l + (1.0f - l) * fast_sigmoid(zc))) }
#undef EPIREC_F_LOOP
        } else {
            bf16_t* O = RQ + (size_t)(seg == 4 ? 2 : seg) * ((size_t)72 << 19);
            const bool act = seg == 0;
#pragma unroll
            for (int ai = 0; ai < 2; ++ai)
#pragma unroll
                for (int m = 0; m < 4; ++m) { bf16_t* rowp = O + (size_t)(row0 + ai * HALF + m * 16) * E_DM + col0;
#pragma unroll
                    for (int bj = 0; bj < 2; ++bj) { f32x4 v0 = acc[ai][bj][m][0], v1 = acc[ai][bj][m][1];
                        if (act) {
#pragma unroll
                            for (int j = 0; j < 4; ++j) { v0[j] = fast_silu(v0[j]); v1[j] = fast_silu(v1[j]); } }
                        u32x4 w; w.x = cvt_pk_bf16(v0[0], v0[1]); w.y = cvt_pk_bf16(v0[2], v0[3]); w.z = cvt_pk_bf16(v1[0], v1[1]); w.w = cvt_pk_bf16(v1[2], v1[3]);
                        *(u32x4*)(rowp + bj * HALF) = w; } }
        }
    }
};


struct EpiPart {
    static constexpr bool PERM = true, AFTER_DRAIN = false;
    f16_t* slab; int ks;
    __device__ __forceinline__ void operator()(const f32x4 (&acc)[2][2][4][2], const Unit& u, int wr, int wc, int fr, int fq) const {
        const int s = u.kofs / ks;
        const int row0 = (u.pm - E_ML / BM) * BM + wr * 64 + fr, col0 = u.pn * BM + wc * 32 + 8 * fq;
        f16_t* op = slab + ((size_t)s * 2048 + row0) * E_DM + col0;
#pragma unroll
        for (int ai = 0; ai < 2; ++ai)
#pragma unroll
            for (int m = 0; m < 4; ++m)
#pragma unroll
                for (int bj = 0; bj < 2; ++bj) { f16x8 r;
#pragma unroll
                    for (int j = 0; j < 4; ++j) { r[j] = (f16_t)acc[ai][bj][m][0][j]; r[4 + j] = (f16_t)acc[ai][bj][m][1][j]; }
                    *(f16x8*)(op + (size_t)(ai * HALF + m * 16) * E_DM + bj * HALF) = r; }
    }
};

template <class Epi, class Sched, bool ALIGN_EPI = false, bool SP2 = false>
__device__ __forceinline__ void gemm_phase(PG8_LAS unsigned char* lds, const Gemm g, const Sched& S, const Epi& E) {
    int tid_o = threadIdx.x; asm volatile("" : "+v"(tid_o));
    const int tid = tid_o, wid = __builtin_amdgcn_readfirstlane(tid >> 6), lane = tid & 63, wr = wid >> 2, wc = wid & 3, fr = lane & 15, fq = lane >> 4;
    const int K = g.K, nt = K / BK, LD = g.ld;
    unsigned voffA[2], voffB[2];
#pragma unroll
    for (int i = 0; i < 2; ++i) { int R, C; stage_rc(tid * 16 + i * 8192, R, C); const int Rb = Epi::PERM ? ((R & ~31) + perm32(R & 31)) : R;
        voffA[i] = (unsigned)(R * LD + C) * 2u; voffB[i] = (unsigned)(Rb * LD + C) * 2u; }
    const size_t kstep = (size_t)(BK * 2);
    const size_t hstep = (size_t)HALF * LD * 2;
    const size_t tstep = 2 * hstep;
    const unsigned ldsw = (unsigned)wid * 1024u;
    const int aoff = lds_byte(wr * 64 + fr, fq * 8), boff = lds_byte(wc * 32 + fr, fq * 8);
#define PG8_SA(b, h) (((b) * 2 + (h)) * HTB)
#define PG8_SB(b, h) ((4 + (b) * 2 + (h)) * HTB)
#define PG8_STAGE(bufoff, gbase, voff) do { _Pragma("unroll") for (int _i = 0; _i < 2; ++_i) \
        __builtin_amdgcn_global_load_lds((const unsigned*)((const char*)(gbase) + (voff)[_i]), (PG8_LAS unsigned*)(lds + (bufoff) + ldsw + _i * 8192), 16, 0, 0); } while (0)
#define PG8_LDA(dst, b, h) do { _Pragma("unroll") for (int m = 0; m < 4; ++m) _Pragma("unroll") for (int k = 0; k < 2; ++k) dst[m][k] = *(const PG8_LAS bf16x8*)(lds + PG8_SA(b, h) + aoff + m * 2048 + k * 1024); } while (0)
#define PG8_LDB(dst, b, h) do { _Pragma("unroll") for (int n = 0; n < 2; ++n) _Pragma("unroll") for (int k = 0; k < 2; ++k) dst[n][k] = *(const PG8_LAS bf16x8*)(lds + PG8_SB(b, h) + boff + n * 2048 + k * 1024); } while (0)
#define PG8_MMA(ai, bj, At, Bt) do { __builtin_amdgcn_s_setprio(1); _Pragma("unroll") for (int m = 0; m < 4; ++m) _Pragma("unroll") for (int n = 0; n < 2; ++n) \
        asm volatile("v_mfma_f32_16x16x32_bf16 %0, %1, %2, %0\n\tv_mfma_f32_16x16x32_bf16 %0, %3, %4, %0" : "+v"(acc[ai][bj][m][n]) : "v"(Bt[n][0]), "v"(At[m][0]), "v"(Bt[n][1]), "v"(At[m][1])); \
        __builtin_amdgcn_s_setprio(0); } while (0)
#define PG8_MMAZ(ai, bj, At, Bt) do { __builtin_amdgcn_s_setprio(1); _Pragma("unroll") for (int m = 0; m < 4; ++m) _Pragma("unroll") for (int n = 0; n < 2; ++n) \
        asm volatile("v_mfma_f32_16x16x32_bf16 %0, %1, %2, 0\n\tv_mfma_f32_16x16x32_bf16 %0, %3, %4, %0" : "+v"(acc[ai][bj][m][n]) : "v"(Bt[n][0]), "v"(At[m][0]), "v"(Bt[n][1]), "v"(At[m][1])); \
        __builtin_amdgcn_s_setprio(0); } while (0)
#define PG8_WAIT_V(n) asm volatile("s_waitcnt vmcnt(" #n ")" ::: "memory")
#define PG8_WAIT_L(n) asm volatile("s_waitcnt lgkmcnt(" #n ")" ::: "memory")
#define PG8_BAR __builtin_amdgcn_s_barrier()
#define PG8_SCHED __builtin_amdgcn_sched_barrier(0)
    Unit cur, nxt; int ui = 0;
    if (!S.next(0, cur)) return;
    f32x4 acc[2][2][4][2];
    {
#pragma unroll
    for (int a = 0; a < 2; ++a)
#pragma unroll
        for (int b = 0; b < 2; ++b)
#pragma unroll
            for (int m = 0; m < 4; ++m)
#pragma unroll
                for (int n = 0; n < 2; ++n) acc[a][b][m][n] = (f32x4){0.f, 0.f, 0.f, 0.f};
    }
    bf16x8 At[4][2], B0[2][2], B1[2][2];
    const char* cA = (const char*)g.A + (size_t)cur.pm * tstep + (size_t)cur.kofs * 2; const char* cB = (const char*)g.Bt + (size_t)cur.pn * tstep + (size_t)cur.kofs * 2;
    S.a_ready(cur);
    if constexpr (SP2) {
        PG8_STAGE(PG8_SB(0, 0), cB, voffB); PG8_STAGE(PG8_SB(0, 1), cB + hstep, voffB); PG8_STAGE(PG8_SA(0, 0), cA, voffA); PG8_STAGE(PG8_SA(0, 1), cA + hstep, voffA);
        if (wr == 1) PG8_BAR;
        PG8_WAIT_V(2); PG8_BAR;
        PG8_STAGE(PG8_SB(1, 0), cB + kstep, voffB); PG8_STAGE(PG8_SA(1, 0), cA + kstep, voffA); PG8_STAGE(PG8_SB(1, 1), cB + hstep + kstep, voffB);
        PG8_WAIT_V(6); PG8_BAR;
    } else {
        PG8_STAGE(PG8_SB(0, 0), cB, voffB); PG8_STAGE(PG8_SA(0, 0), cA, voffA); PG8_STAGE(PG8_SB(0, 1), cB + hstep, voffB); PG8_STAGE(PG8_SA(0, 1), cA + hstep, voffA);
        if (wr == 1) PG8_BAR;
        PG8_WAIT_V(4); PG8_BAR;
        PG8_STAGE(PG8_SB(1, 0), cB + kstep, voffB); PG8_STAGE(PG8_SA(1, 0), cA + kstep, voffA); PG8_STAGE(PG8_SB(1, 1), cB + hstep + kstep, voffB);
        PG8_WAIT_V(6); PG8_BAR;
    }
    for (;;) {
        const bool has_next = S.next(ui + 1, nxt);
        const char* nA = has_next ? (const char*)g.A + (size_t)nxt.pm * tstep + (size_t)nxt.kofs * 2 : cA; const char* nB = has_next ? (const char*)g.Bt + (size_t)nxt.pn * tstep + (size_t)nxt.kofs * 2 : cB;
#define PG8_KSETUP(t) const bool last = ((t) == nt - 2); \
            const char* a1 = cA + (size_t)((t) + 1) * kstep;                                           \
            const char* a2 = last ? nA : cA + (size_t)((t) + 2) * kstep; const char* b2 = last ? nB : cB + (size_t)((t) + 2) * kstep;     \
            const char* a3 = a2 + kstep; const char* b3 = b2 + kstep;                                \
            if (last && has_next) S.a_ready(nxt);
#define PG8_KBODY(MF) \
            PG8_LDB(B0, 0, 0); PG8_LDB(B1, 0, 1); PG8_SCHED; PG8_LDA(At, 0, 0); PG8_STAGE(PG8_SA(1, 1), a1 + hstep, voffA); \
            PG8_WAIT_V(8); PG8_WAIT_L(0); PG8_BAR; MF(0, 0, At, B0); MF(0, 1, At, B1); PG8_BAR; PG8_SCHED; \
            PG8_LDA(At, 0, 1); PG8_STAGE(PG8_SB(0, 0), b2, voffB); PG8_STAGE(PG8_SB(0, 1), b2 + hstep, voffB); PG8_STAGE(PG8_SA(0, 0), a2, voffA); \
            PG8_WAIT_V(8); PG8_WAIT_L(0); PG8_BAR; MF(1, 0, At, B0); MF(1, 1, At, B1); PG8_BAR; PG8_SCHED; \
            PG8_LDB(B0, 1, 0); PG8_LDB(B1, 1, 1); PG8_SCHED; PG8_LDA(At, 1, 0); PG8_STAGE(PG8_SA(0, 1), a2 + hstep, voffA); \
            PG8_WAIT_V(8); PG8_WAIT_L(0); PG8_BAR; PG8_MMA(0, 0, At, B0); PG8_MMA(0, 1, At, B1); PG8_BAR; PG8_SCHED; \
            PG8_LDA(At, 1, 1); PG8_STAGE(PG8_SB(1, 0), b3, voffB); PG8_STAGE(PG8_SB(1, 1), b3 + hstep, voffB); PG8_STAGE(PG8_SA(1, 0), a3, voffA); \
            PG8_WAIT_V(8); PG8_WAIT_L(0); PG8_BAR; PG8_MMA(1, 0, At, B0); PG8_MMA(1, 1, At, B1); PG8_BAR; PG8_SCHED;
        if constexpr (SP2) {
            { PG8_KSETUP(0) PG8_KBODY(PG8_MMAZ) }
            for (int t = 2; t < nt; t += 2) { PG8_KSETUP(t) PG8_KBODY(PG8_MMA) }
        } else
        for (int t = 0; t < nt; t += 2) {
            const bool last = (t == nt - 2);
            const char* a1 = cA + (size_t)(t + 1) * kstep;
            const char* a2 = last ? nA : cA + (size_t)(t + 2) * kstep; const char* b2 = last ? nB : cB + (size_t)(t + 2) * kstep;
            const char* a3 = a2 + kstep; const char* b3 = b2 + kstep;
            if (last && has_next) S.a_ready(nxt);
            {
            PG8_LDB(B0, 0, 0); PG8_SCHED; PG8_LDA(At, 0, 0); PG8_STAGE(PG8_SA(1, 1), a1 + hstep, voffA);
            PG8_WAIT_L(8); PG8_BAR; PG8_WAIT_L(0); PG8_MMA(0, 0, At, B0); PG8_BAR; PG8_SCHED;
            PG8_LDB(B1, 0, 1); PG8_STAGE(PG8_SB(0, 0), b2, voffB);
            PG8_BAR; PG8_WAIT_L(0); PG8_MMA(0, 1, At, B1); PG8_BAR;
            PG8_LDA(At, 0, 1); PG8_STAGE(PG8_SA(0, 0), a2, voffA);
            PG8_BAR; PG8_WAIT_L(0); PG8_MMA(1, 0, At, B0); PG8_BAR; PG8_SCHED;
            PG8_STAGE(PG8_SB(0, 1), b2 + hstep, voffB);
            PG8_WAIT_V(6); PG8_BAR; PG8_MMA(1, 1, At, B1); PG8_BAR;
            PG8_LDB(B0, 1, 0); PG8_SCHED; PG8_LDA(At, 1, 0); PG8_STAGE(PG8_SA(0, 1), a2 + hstep, voffA);
            PG8_WAIT_L(8); PG8_BAR; PG8_WAIT_L(0); PG8_MMA(0, 0, At, B0); PG8_BAR; PG8_SCHED;
            PG8_LDB(B1, 1, 1); PG8_STAGE(PG8_SB(1, 0), b3, voffB);
            PG8_BAR; PG8_WAIT_L(0); PG8_MMA(0, 1, At, B1); PG8_BAR;
            PG8_LDA(At, 1, 1); PG8_STAGE(PG8_SA(1, 0), a3, voffA);
            PG8_BAR; PG8_WAIT_L(0); PG8_MMA(1, 0, At, B0); PG8_BAR; PG8_SCHED;
            PG8_STAGE(PG8_SB(1, 1), b3 + hstep, voffB);
            PG8_WAIT_V(6); PG8_BAR; PG8_MMA(1, 1, At, B1); PG8_BAR;
            }
        }
        if constexpr (ALIGN_EPI) { if (wr == 0) PG8_BAR; }
        if constexpr (!Epi::AFTER_DRAIN) { E(acc, cur, wr, wc, fr, fq); S.done(cur); }
        if (!has_next) break;
        if constexpr (!SP2) {
#pragma unroll
        for (int a = 0; a < 2; ++a)
#pragma unroll
            for (int b = 0; b < 2; ++b)
#pragma unroll
                for (int m = 0; m < 4; ++m)
#pragma unroll
                    for (int n = 0; n < 2; ++n) acc[a][b][m][n] = (f32x4){0.f, 0.f, 0.f, 0.f};
        }
        cur = nxt; cA = nA; cB = nB; ++ui;
        if constexpr (ALIGN_EPI) { if (wr == 1) PG8_BAR; }
    }
    PG8_WAIT_V(0);
    if constexpr (!ALIGN_EPI) { if (wr == 0) PG8_BAR; }
    PG8_BAR;
    if constexpr (Epi::AFTER_DRAIN) { E.fused(acc, cur, wr, wc, fr, fq, lds, wid, lane); S.done(cur); }
#undef PG8_SA
#undef PG8_SB
#undef PG8_STAGE
#undef PG8_LDA
#undef PG8_LDB
#undef PG8_MMA
#undef PG8_MMAZ
#undef PG8_KSETUP
#undef PG8_KBODY
#undef PG8_WAIT_V
#undef PG8_WAIT_L
#undef PG8_BAR
#undef PG8_SCHED
}
}

#define GAS __attribute__((address_space(1)))
#define LAS __attribute__((address_space(3)))
typedef unsigned short bf16;
typedef unsigned v4u __attribute__((ext_vector_type(4)));
typedef float f32x4 __attribute__((ext_vector_type(4)));
typedef short bf16x8 __attribute__((ext_vector_type(8)));
typedef GAS unsigned gu32;
typedef GAS unsigned long long gu64;
#define RLX_AGENT __ATOMIC_RELAXED, __HIP_MEMORY_SCOPE_AGENT
#define LDS_WAIT() asm volatile("s_waitcnt lgkmcnt(0)" ::: "memory")
#define VM_WAIT() asm volatile("s_waitcnt vmcnt(0)" ::: "memory")
__device__ __forceinline__ unsigned long long rt() { return __builtin_amdgcn_s_memrealtime(); }
__device__ __forceinline__ unsigned f2bf(float f) { unsigned u = __builtin_bit_cast(unsigned, f); return (u + 0x7fffu + ((u >> 16) & 1u)) >> 16; }
__device__ __forceinline__ unsigned pk2(float lo, float hi) { return f2bf(lo) | (f2bf(hi) << 16); }

#define XB_TMO      128
#define XB_XCNT(j)  (256  + 64 * (j))
#define XB_XSUB(j)  (1280 + 64 * (j))
#define XB_XGEN(j)  (2304 + 64 * (j))
#define XB_TOP      3328
#define XB_TOPGEN   3392
#define XCD_BAR_WORDS 3456
#define XB_SPIN_CAP (1u << 18)

__device__ __forceinline__ unsigned xb_ld(unsigned* p)              { return __hip_atomic_load(p, __ATOMIC_RELAXED, __HIP_MEMORY_SCOPE_AGENT); }
__device__ __forceinline__ unsigned xb_add(unsigned* p, unsigned v) { return __hip_atomic_fetch_add(p, v, __ATOMIC_RELAXED, __HIP_MEMORY_SCOPE_AGENT); }
__device__ __forceinline__ unsigned xb_xcc_id() { return (unsigned)__builtin_amdgcn_s_getreg((3 << 11) | 20) & 0xFu; }
#define XB_SPIN(cond, bar) do { unsigned _sp = 0; while (cond) { __builtin_amdgcn_s_sleep(1); \
    if ((++_sp & 255u) == 0u) { if (xb_ld(&(bar)[XB_TMO])) break; if (_sp > XB_SPIN_CAP) { atomicAdd(&(bar)[XB_TMO], 1u); break; } } } } while (0)

struct XcdBarrier {
    unsigned* bar; unsigned x;
    volatile LAS unsigned* st;
};

__device__ __forceinline__ XcdBarrier xcd_barrier_post(unsigned* bar, volatile LAS unsigned* st) {
    XcdBarrier b; b.bar = bar; b.x = xb_xcc_id(); b.st = st;
    if (threadIdx.x == 0) (void)xb_add(&bar[XB_XCNT(b.x)], 1u);
    return b;
}
__device__ __forceinline__ void xcd_barrier_complete(unsigned* bar, unsigned x, unsigned& nloc, unsigned& nx) {
    const unsigned G = gridDim.x * gridDim.y * gridDim.z;
    unsigned sum, cnt, mine, sp = 0u;
    for (;;) {
        sum = 0u; cnt = 0u; mine = 0u;
#pragma unroll
        for (unsigned j = 0; j < 16; ++j) { const unsigned c = xb_ld(&bar[XB_XCNT(j)]); sum += c; cnt += (c > 0u) ? 1u : 0u; mine = (j == x) ? c : mine; }
        if (sum == G) break;
        __builtin_amdgcn_s_sleep(1);
        if ((++sp & 255u) == 0u) { if (xb_ld(&bar[XB_TMO])) break; if (sp > XB_SPIN_CAP) { atomicAdd(&bar[XB_TMO], 1u); break; } }
    }
    nloc = mine > 0u ? mine : 1u; nx = cnt > 0u ? cnt : 1u;
}

__device__ __forceinline__ void xcd_barrier(const XcdBarrier& b) {
    asm volatile("s_waitcnt vmcnt(0)" ::: "memory");
    __syncthreads();
    if (threadIdx.x == 0) {
        unsigned* bar = b.bar;
        __builtin_amdgcn_s_waitcnt(0);
        unsigned nloc = b.st[0], nx = b.st[1];
        if (nloc == 0u) { xcd_barrier_complete(bar, b.x, nloc, nx); b.st[0] = nloc; b.st[1] = nx; }
        const unsigned old = xb_add(&bar[XB_XSUB(b.x)], 1u);
        const unsigned gen = old / nloc;
        if (old + 1u == (gen + 1u) * nloc) {
            __builtin_amdgcn_fence(__ATOMIC_RELEASE, "agent");
            asm volatile("s_waitcnt vmcnt(0)" ::: "memory");
            const unsigned og = xb_add(&bar[XB_TOP], 1u);
            const unsigned tg = og / nx;
            if (og + 1u == (tg + 1u) * nx) xb_add(&bar[XB_TOPGEN], 1u);
            else XB_SPIN(xb_ld(&bar[XB_TOPGEN]) == tg, bar);
            __builtin_amdgcn_fence(__ATOMIC_ACQUIRE, "agent");
            xb_add(&bar[XB_XGEN(b.x)], 1u);
            asm volatile("s_waitcnt vmcnt(0)" ::: "memory");
        } else {
            XB_SPIN(xb_ld(&bar[XB_XGEN(b.x)]) == gen, bar);
            __builtin_amdgcn_fence(__ATOMIC_ACQUIRE, "agent");
            asm volatile("s_waitcnt vmcnt(0)" ::: "memory");
        }
    }
    __syncthreads();
}


namespace att {
using bf16x8 = __attribute__((ext_vector_type(8))) short;
using s16x4  = __attribute__((ext_vector_type(4))) short;
using f32x16 = __attribute__((ext_vector_type(16))) float;
using u32x4  = __attribute__((ext_vector_type(4))) unsigned;
constexpr int D = 128, NW = 8, QBLK = 32, KVBLK = 64;
constexpr int LDQ = 3072, LDO = 2048;
constexpr float SCALE = 0.088388347648318440f;
constexpr float THR = 4.f;
constexpr size_t SHM_V = KVBLK * D * 2, SHM_K = KVBLK * D * 2, NBUF = 3, SHM_ATTN = NBUF * SHM_V + NBUF * SHM_K + NW * 64 * 4;
#define KSWZ(row, colB) ((row) * 256 + ((colB) ^ (((row) & 7) << 4)))
#define SBAR() __builtin_amdgcn_sched_barrier(0)
__device__ __forceinline__ int crow(int r, int hi) { return (r & 3) + 8 * (r >> 2) + 4 * hi; }
__device__ __forceinline__ unsigned cvtpk(float lo, float hi) { unsigned r; asm volatile("v_cvt_pk_bf16_f32 %0, %1, %2" : "=v"(r) : "v"(lo), "v"(hi)); return r; }

__device__ __forceinline__ void partialSM(f32x16& p0, f32x16& p1, float& m_reg, float& mn, float& alpha) {
  constexpr float C = SCALE * 1.4426950408889634f;
  float pmax = p0[0];
#pragma unroll
  for (int r = 1; r < 16; ++r) pmax = fmaxf(pmax, p0[r]);
#pragma unroll
  for (int r = 0; r < 16; ++r) pmax = fmaxf(pmax, p1[r]);
  { auto rr = __builtin_amdgcn_permlane32_swap(__float_as_uint(pmax), __float_as_uint(pmax), false, false);
    pmax = fmaxf(__uint_as_float(rr[0]), __uint_as_float(rr[1])); }
  if (__builtin_expect(__all(pmax - m_reg <= THR / SCALE), 1)) { mn = m_reg; alpha = 1.f; }
  else { mn = fmaxf(m_reg, pmax); alpha = __builtin_amdgcn_exp2f((m_reg - mn) * C); m_reg = mn; }
  float mnC = -mn * C;
#pragma unroll
  for (int r = 0; r < 16; ++r) p0[r] = fmaf(p0[r], C, mnC);
#pragma unroll
  for (int r = 0; r < 16; ++r) p1[r] = fmaf(p1[r], C, mnC);
#pragma unroll
  for (int r = 0; r < 16; ++r) p0[r] = __builtin_amdgcn_exp2f(p0[r]);
}
__device__ __forceinline__ void finishSM(f32x16& p0, f32x16& p1, float alpha, float& l_reg, bf16x8& pa0, bf16x8& pa1, bf16x8& pa2, bf16x8& pa3) {
#pragma unroll
  for (int r = 0; r < 16; ++r) p1[r] = __builtin_amdgcn_exp2f(p1[r]);
  float ps = 0;
#pragma unroll
  for (int r = 0; r < 16; ++r) ps += p0[r];
#pragma unroll
  for (int r = 0; r < 16; ++r) ps += p1[r];
  { auto rr = __builtin_amdgcn_permlane32_swap(__float_as_uint(ps), __float_as_uint(ps), false, false);
    ps = __uint_as_float(rr[0]) + __uint_as_float(rr[1]); }
  l_reg = l_reg * alpha + ps;
#define PK4(P, BASE, OUT) do { unsigned a0 = cvtpk(P[BASE + 0], P[BASE + 1]), a1 = cvtpk(P[BASE + 2], P[BASE + 3]);   \
    unsigned b0 = cvtpk(P[BASE + 4], P[BASE + 5]), b1 = cvtpk(P[BASE + 6], P[BASE + 7]);                              \
    auto r0 = __builtin_amdgcn_permlane32_swap(a0, b0, false, false); auto r1 = __builtin_amdgcn_permlane32_swap(a1, b1, false, false); \
    u32x4 w = {r0[0], r1[0], r0[1], r1[1]}; OUT = *reinterpret_cast<bf16x8*>(&w); } while (0)
  PK4(p0, 0, pa0); PK4(p0, 8, pa1); PK4(p1, 0, pa2); PK4(p1, 8, pa3);
#undef PK4
}
__device__ __forceinline__ void qkt(f32x16& p0, f32x16& p1, const char* Ks, const bf16x8* qr, int r32, int hi) {
  p0 = f32x16{}; p1 = f32x16{};
#pragma unroll
  for (int d0 = 0; d0 < 8; ++d0) { int cb = (d0 * 16 + hi * 8) * 2;
    bf16x8 b0 = *reinterpret_cast<const bf16x8*>(Ks + KSWZ(r32, cb));
    bf16x8 b1 = *reinterpret_cast<const bf16x8*>(Ks + KSWZ(32 + r32, cb));
    p0 = __builtin_amdgcn_mfma_f32_32x32x16_bf16(b0, qr[d0], p0, 0, 0, 0);
    p1 = __builtin_amdgcn_mfma_f32_32x32x16_bf16(b1, qr[d0], p1, 0, 0, 0); }
}
__device__ __forceinline__ void mask_tile(f32x16& p0, f32x16& p1, int dlt0, int hi) {
#pragma unroll
  for (int r = 0; r < 16; ++r) { const int d = dlt0 + crow(r, hi);
    if (d < -128 || d > 128) p0[r] = -1e30f;
    if (d + 32 < -128 || d + 32 > 128) p1[r] = -1e30f; }
}
__device__ __forceinline__ int v_st(int k, int c) { const int kk = (k & ~0xC) | ((k & 4) << 1) | ((k & 8) >> 1); return ((kk >> 3) * 4 + (c >> 5)) * 512 + ((kk & 7) * 32 + (c & 31)) * 2; }
__device__ __forceinline__ int v_rd_base(int lane) { return ((lane & 3) << 3) | (((lane >> 2) & 3) << 6) | (((lane >> 4) & 1) << 5) | (((lane >> 5) & 1) << 8); }
constexpr int v_rd_off(int d0, int ks, int half) { return d0 * 512 + ks * 4096 + half * 2048; }
template <int OFF> __device__ __forceinline__ s16x4 tr_read(int vb) {
  s16x4 r; asm volatile("ds_read_b64_tr_b16 %0, %1 offset:%2" : "=&v"(r) : "v"(vb), "i"(OFF) : "memory"); return r;
}
template <int D0> __device__ __forceinline__ void pv_one(f32x16& od, int vb, bf16x8 pa0, bf16x8 pa1, bf16x8 pa2, bf16x8 pa3) {
  const s16x4 l0 = tr_read<v_rd_off(D0, 0, 0)>(vb), h0 = tr_read<v_rd_off(D0, 0, 1)>(vb), l1 = tr_read<v_rd_off(D0, 1, 0)>(vb), h1 = tr_read<v_rd_off(D0, 1, 1)>(vb);
  const s16x4 l2 = tr_read<v_rd_off(D0, 2, 0)>(vb), h2 = tr_read<v_rd_off(D0, 2, 1)>(vb), l3 = tr_read<v_rd_off(D0, 3, 0)>(vb), h3 = tr_read<v_rd_off(D0, 3, 1)>(vb);
  asm volatile("s_waitcnt lgkmcnt(0)" ::: "memory"); SBAR();
#define PK(L, H) (bf16x8){L[0], L[1], L[2], L[3], H[0], H[1], H[2], H[3]}
  od = __builtin_amdgcn_mfma_f32_32x32x16_bf16(pa0, PK(l0, h0), od, 0, 0, 0);
  od = __builtin_amdgcn_mfma_f32_32x32x16_bf16(pa1, PK(l1, h1), od, 0, 0, 0);
  od = __builtin_amdgcn_mfma_f32_32x32x16_bf16(pa2, PK(l2, h2), od, 0, 0, 0);
  od = __builtin_amdgcn_mfma_f32_32x32x16_bf16(pa3, PK(l3, h3), od, 0, 0, 0);
#undef PK
}
__device__ __forceinline__ void pv_d0(f32x16* o, int vb, bf16x8 pa0, bf16x8 pa1, bf16x8 pa2, bf16x8 pa3) {
  pv_one<0>(o[0], vb, pa0, pa1, pa2, pa3); pv_one<1>(o[1], vb, pa0, pa1, pa2, pa3); pv_one<2>(o[2], vb, pa0, pa1, pa2, pa3); pv_one<3>(o[3], vb, pa0, pa1, pa2, pa3);
}

struct UnitP { int qrow0, hd0, grp, kcol, vcol, win_row0, kpos_start, nwin, ctx_row0, qpos0, pad; };
__device__ __forceinline__ UnitP unit_params(int u) {
  constexpr int SEQ_ = 2048, ML_ = 16384, CTXL_ = 256;
  UnitP P;
  if (u < 1024) { const int qb = u & 31, hk = (u >> 5) & 3, b = u >> 7;
    const int P0 = qb * 64; const int k0 = (P0 - 128 < 0) ? 0 : P0 - 128, k1 = (P0 + 192 > SEQ_) ? SEQ_ : P0 + 192; const int n = (k1 - k0) >> 6;
    P.pad = n & 1;
    P.qrow0 = b * SEQ_ + P0; P.hd0 = hk * 4; P.grp = 1; P.kcol = 2048 + hk * 128; P.vcol = 2560 + hk * 128; P.win_row0 = b * SEQ_ + k0; P.kpos_start = k0; P.nwin = n;
    P.ctx_row0 = ML_ + b * CTXL_; P.qpos0 = P0; }
  else { const int uc = u - 1024, h = uc & 15, b = uc >> 4, hk = h >> 2;
    P.qrow0 = ML_ + b * CTXL_; P.hd0 = h; P.grp = 0; P.kcol = 2048 + hk * 128; P.vcol = 2560 + hk * 128; P.win_row0 = 0; P.kpos_start = 0; P.nwin = 0; P.ctx_row0 = ML_ + b * CTXL_; P.qpos0 = 0; P.pad = 0; }
  return P;
}
__device__ __forceinline__ int unit_at(int i, int c, int G) {
  if (G == 256) {
    if (i < 4) return c + 256 * i;
    const int qb = c & 31; const bool edge = qb < 2 || qb >= 30;
    if (edge) { const int r = ((c >> 5) << 2) + (qb < 2 ? qb : qb - 28); return i < 6 ? 1024 + 2 * r + (i - 4) : -1; }
    const int s = (c >> 5) * 28 + (qb - 2);
    return (i == 4 && s < 64) ? 1024 + 64 + s : -1;
  }
  const int u = c + G * i; return u < 1024 + 128 ? u : -1;
}
__device__ __forceinline__ void attn_units(const unsigned short* __restrict__ QKV, unsigned short* __restrict__ Og, const float* sinkp, int u0, int ustep, char* lds) {
  int tid_o = threadIdx.x; asm volatile("" : "+v"(tid_o));
  asm volatile("" : "+s"(u0));
  const int tid = tid_o, wid = __builtin_amdgcn_readfirstlane(tid >> 6), lane = tid & 63, r32 = lane & 31, hi = lane >> 5;
#define WROW(PP) ((PP).grp ? 32 * (wid & 1) : 32 * wid)
#define WHEAD(PP) ((PP).hd0 + ((PP).grp ? (wid >> 1) : 0))
  char* V_lds = lds; char* K_lds = lds + NBUF * SHM_V;
  float* ws = (float*)(lds + NBUF * SHM_V + NBUF * SHM_K) + wid * 64; float* li_l = ws; float* al_l = ws + 32;
  const int sr = tid >> 4, sc = (tid & 15) * 8, vst0 = v_st(sr, sc), vst1 = v_st(32 + sr, sc);
  const int vb0 = (int)(uintptr_t)V_lds + v_rd_base(lane);
  bf16x8 qr[8];
  struct { bf16x8 vs0, vs1, ks0, ks1; } sr_[2];
  constexpr int SE = 0, SO = 1;
#define TROWP(PP, j) ((j) < (PP).nwin ? (PP).win_row0 + 64 * (j) : (PP).ctx_row0 + 64 * (((j) - (PP).nwin) & 3))
#define SLOADP(PP, i, j) do { const unsigned short* tb_ = QKV + (size_t)(TROWP(PP, j) + sr) * LDQ + sc; \
    sr_[i].vs0 = *reinterpret_cast<const bf16x8*>(tb_ + (PP).vcol); sr_[i].vs1 = *reinterpret_cast<const bf16x8*>(tb_ + (size_t)32 * LDQ + (PP).vcol); \
    sr_[i].ks0 = *reinterpret_cast<const bf16x8*>(tb_ + (PP).kcol); sr_[i].ks1 = *reinterpret_cast<const bf16x8*>(tb_ + (size_t)32 * LDQ + (PP).kcol); } while (0)
#define QLOADP(PP) do { const unsigned short* Qw_ = QKV + (size_t)((PP).qrow0 + WROW(PP) + r32) * LDQ + WHEAD(PP) * 128 + hi * 8; \
    _Pragma("unroll") for (int d0 = 0; d0 < 8; ++d0) qr[d0] = *reinterpret_cast<const bf16x8*>(Qw_ + d0 * 16); } while (0)
#define SLOAD(i, j) SLOADP(P, i, j)
#define SWRITE(b, i) do { *(bf16x8*)(V_lds + (b) * SHM_V + vst0) = sr_[i].vs0; *(bf16x8*)(V_lds + (b) * SHM_V + vst1) = sr_[i].vs1; int kc = sc * 2; \
    *(bf16x8*)(K_lds + (b) * SHM_K + KSWZ(sr, kc)) = sr_[i].ks0; *(bf16x8*)(K_lds + (b) * SHM_K + KSWZ(32 + sr, kc)) = sr_[i].ks1; } while (0)
#define SWAIT() asm volatile("s_waitcnt vmcnt(4)" ::: "memory")
#define RESC(a) do { if (__any((a) < 1.f)) { if (hi == 0) al_l[r32] = (a); asm volatile("s_waitcnt lgkmcnt(0)" ::: "memory"); \
    _Pragma("unroll") for (int d = 0; d < 4; ++d) _Pragma("unroll") for (int r = 0; r < 16; ++r) o[d][r] *= al_l[crow(r, hi)]; } } while (0)
#define MASK(P0_, P1_, j) do { if ((j) < nwin) { const int kp0_ = P.kpos_start + 64 * (j); \
    if (!(kp0_ - (qpmin + 31) >= -128 && kp0_ + 63 - qpmin <= 128)) mask_tile(P0_, P1_, kp0_ - qpos, hi); } } while (0)
  int ucur = unit_at(0, u0, ustep);
  if (ucur < 0) return;
  UnitP P = unit_params(ucur);
  QLOADP(P); SLOADP(P, SE, 0);
  for (int ui = 0; ucur >= 0; ++ui) {
    const int unext = unit_at(ui + 1, u0, ustep);
    const bool has_next = unext >= 0;
    const UnitP PN = unit_params(has_next ? unext : ucur);
    const int nwin = P.nwin, NT = nwin + 4 + P.pad;
    const int qpos = P.qpos0 + WROW(P) + r32, qpmin = P.qpos0 + WROW(P);
    float m_reg = sinkp[WHEAD(P)] * (1.0f / SCALE), l_reg = 1.f; f32x16 o[4] = {};
    f32x16 pA0, pA1, pB0, pB1; float mnA, mnB, alA, alB; bf16x8 pa0, pa1, pa2, pa3;
#define KB(b) (K_lds + (b) * SHM_K)
#define VB(b) (vb0 + (int)((b) * SHM_V))
#define INC3(b) ((b) == 2 ? 0 : (b) + 1)
    SWRITE(0, SE); __syncthreads();
    qkt(pA0, pA1, KB(0), qr, r32, hi); MASK(pA0, pA1, 0); partialSM(pA0, pA1, m_reg, mnA, alA);
    SLOAD(SO, 1); if (2 < NT) SLOAD(SE, 2);
    SWAIT(); SWRITE(1, SO); __syncthreads();
    int bj = 1;
    for (int j = 1; j + 1 < NT; j += 2) {
      const int bp = INC3(bj), bm = INC3(bp);
      SBAR(); qkt(pB0, pB1, KB(bj), qr, r32, hi);
      finishSM(pA0, pA1, alA, l_reg, pa0, pa1, pa2, pa3); SBAR();
      SLOAD(SO, j + 2); SBAR();
      pv_d0(o, VB(bm), pa0, pa1, pa2, pa3); MASK(pB0, pB1, j); partialSM(pB0, pB1, m_reg, mnB, alB);
      SWAIT(); SWRITE(bp, SE);
      RESC(alB); __syncthreads();
      SBAR(); qkt(pA0, pA1, KB(bp), qr, r32, hi);
      finishSM(pB0, pB1, alB, l_reg, pa0, pa1, pa2, pa3); SBAR();
      if (j + 3 < NT) SLOAD(SE, j + 3); SBAR();
      pv_d0(o, VB(bj), pa0, pa1, pa2, pa3); MASK(pA0, pA1, j + 1); partialSM(pA0, pA1, m_reg, mnA, alA);
      SWAIT(); SWRITE(bm, SO);
      RESC(alA); __syncthreads();
      bj = bm;
    }
    const bool real = P.pad == 0;
    { const int bm = INC3(INC3(bj));
    SBAR(); qkt(pB0, pB1, KB(bj), qr, r32, hi);
    finishSM(pA0, pA1, alA, l_reg, pa0, pa1, pa2, pa3); SBAR();
    pv_d0(o, VB(bm), pa0, pa1, pa2, pa3);
    if (real) { MASK(pB0, pB1, NT - 1); partialSM(pB0, pB1, m_reg, mnB, alB);
      RESC(alB);
      finishSM(pB0, pB1, alB, l_reg, pa0, pa1, pa2, pa3); SBAR();
      pv_d0(o, VB(bj), pa0, pa1, pa2, pa3); } }
    if (has_next) { QLOADP(PN); SLOADP(PN, SE, 0); }
    if (hi == 0) li_l[r32] = l_reg; asm volatile("s_waitcnt lgkmcnt(0)" ::: "memory");
    float rli[16];
#pragma unroll
    for (int r = 0; r < 16; ++r) rli[r] = __builtin_amdgcn_rcpf(li_l[crow(r, hi)]);
    unsigned short* Ow = Og + (size_t)(P.qrow0 + WROW(P)) * LDO + WHEAD(P) * 128;
#pragma unroll
    for (int r = 0; r < 16; ++r) { const int orow = crow(r, hi);
#pragma unroll
      for (int d0 = 0; d0 < 4; ++d0) { const unsigned w = cvtpk(o[d0][r] * rli[r], 0.f); Ow[(size_t)orow * LDO + d0 * 32 + r32] = (unsigned short)(w & 0xffffu); } }
    __syncthreads();
    P = PN; ucur = unext;
  }
#undef KB
#undef VB
#undef INC3
#undef WROW
#undef WHEAD
#undef TROWP
#undef SLOADP
#undef QLOADP
#undef SLOAD
#undef SWRITE
#undef SWAIT
#undef RESC
#undef MASK
}
#undef KSWZ
#undef SBAR
}


namespace scn {
using bf16x8 = __attribute__((ext_vector_type(8))) short;
using f32x4  = __attribute__((ext_vector_type(4))) float;
using f32x2  = __attribute__((ext_vector_type(2))) float;
using u32x4  = __attribute__((ext_vector_type(4))) unsigned;
using u32x2  = __attribute__((ext_vector_type(2))) unsigned;
using f16x2  = __attribute__((ext_vector_type(2))) _Float16;
constexpr int CH = 32, NCHUNK = 72, NCTXCH = 8;
constexpr float DCLAMP = -115.41560327111707f;
constexpr int QK_STRIDE = 272, T_STRIDE = 80;
constexpr int QS = 0, KS = QS + CH * QK_STRIDE, KT = KS + CH * QK_STRIDE, VT = KT + 128 * T_STRIDE, BUF_BYTES = VT + 128 * T_STRIDE;
constexpr int PS0 = 3 * BUF_BYTES, PS_BYTES = CH * T_STRIDE, TT0 = PS0 + 2 * PS_BYTES, TT_BYTES = 8 * 128 * 4, SC0 = TT0 + 2 * TT_BYTES, SC_BYTES = 512, SCAN_LDS = SC0 + 4 * SC_BYTES;
constexpr int OS0 = 135168, OS1 = 147456, OS_STRIDE = 272, OS_BYTES = CH * OS_STRIDE, SCAN_LDS_TOP = OS1 + OS_BYTES;
static_assert(SCAN_LDS <= 131072 && (BUF_BYTES % 16) == 0 && (KT % 16) == 0 && (VT % 16) == 0 && (PS0 % 16) == 0 && (PS_BYTES % 16) == 0 && (TT0 % 16) == 0 && (SC0 % 16) == 0, "scan LDS");
__device__ __forceinline__ unsigned cvtpk(float lo, float hi) { unsigned r; asm volatile("v_cvt_pk_bf16_f32 %0, %1, %2" : "=v"(r) : "v"(lo), "v"(hi)); return r; }
__device__ __forceinline__ float bflo(unsigned w) { return __uint_as_float(w << 16); }
__device__ __forceinline__ float bfhi(unsigned w) { return __uint_as_float(w & 0xffff0000u); }

__device__ __forceinline__ int tok_row(int b, int dir, int ci, int tt) {
    if (ci < NCTXCH) { const int n = ci * CH + tt; return 16384 + b * 256 + (dir ? 255 - n : n); }
    const int n = (ci - NCTXCH) * CH + tt; return b * 2048 + (dir ? 2047 - n : n);
}
struct ScanCtx { const unsigned short* RQ; const unsigned short* RV; const _Float16* LFd; unsigned short* OUT; int b, h, dir, w; unsigned col2; unsigned so[4]; };
struct ChunkIn { unsigned lfr[4]; unsigned qv[4], vv[4]; float cA[4], cB[4]; };

__device__ __forceinline__ void scan_load(ChunkIn& I, const ScanCtx& C, int ci) {
#pragma unroll
    for (int i = 0; i < 4; ++i) { const size_t rb = (size_t)tok_row(C.b, C.dir, ci, 4 * C.w + i) * 2048 + C.h * 128;
        I.lfr[i] = *(const unsigned*)(C.LFd + rb + C.col2); I.qv[i] = *(const unsigned*)(C.RQ + rb + C.col2); I.vv[i] = *(const unsigned*)(C.RV + rb + C.col2); }
}
__device__ __forceinline__ void scan_cum(ChunkIn& I, char* lds, int ci, int w, int k2) {
    float sA = 0.f, sB = 0.f;
#pragma unroll
    for (int i = 0; i < 4; ++i) { const f16x2 l2 = __builtin_bit_cast(f16x2, I.lfr[i]); sA += (float)l2.x; sB += (float)l2.y; I.cA[i] = sA; I.cB[i] = sB; }
    *(f32x2*)(lds + TT0 + (ci & 1) * TT_BYTES + (w * 128 + 2 * k2) * 4) = (f32x2){sA, sB};
}
__device__ __forceinline__ void scan_prep(const ChunkIn& I, char* lds, int bo, int ci, int w, int k2) {
    float offA = 0.f, offB = 0.f, totA = 0.f, totB = 0.f;
#pragma unroll
    for (int s = 0; s < 8; ++s) { const f32x2 t = *(const f32x2*)(lds + TT0 + (ci & 1) * TT_BYTES + (s * 128 + 2 * k2) * 4);
        const float ms = (s < w) ? 1.0f : 0.0f;
        offA = fmaf(t.x, ms, offA); offB = fmaf(t.y, ms, offB); totA += t.x; totB += t.y; }
    unsigned qt[4], kt[4]; float kA_[4], kB_[4];
#pragma unroll
    for (int i = 0; i < 4; ++i) {
        const float dA = fmaxf(offA + I.cA[i], DCLAMP), dB = fmaxf(offB + I.cB[i], DCLAMP);
        const float eA = __builtin_amdgcn_exp2f(dA), eB = __builtin_amdgcn_exp2f(dB), ieA = __builtin_amdgcn_exp2f(-dA), ieB = __builtin_amdgcn_exp2f(-dB);
        const f16x2 l2 = __builtin_bit_cast(f16x2, I.lfr[i]);
        const float kkA = 1.0f - __builtin_amdgcn_exp2f((float)l2.x), kkB = 1.0f - __builtin_amdgcn_exp2f((float)l2.y);
        const float qA = bflo(I.qv[i]) * eA, qB = bfhi(I.qv[i]) * eB; kA_[i] = kkA * ieA; kB_[i] = kkB * ieB;
        qt[i] = cvtpk(qA, qB); kt[i] = cvtpk(kA_[i], kB_[i]);
    }
    char* B = lds + bo;
#pragma unroll
    for (int i = 0; i < 4; ++i) { *(unsigned*)(B + QS + (4 * w + i) * QK_STRIDE + 4 * k2) = qt[i]; *(unsigned*)(B + KS + (4 * w + i) * QK_STRIDE + 4 * k2) = kt[i]; }
    *(u32x2*)(B + KT + (2 * k2) * T_STRIDE + 8 * w) = (u32x2){cvtpk(kA_[0], kA_[1]), cvtpk(kA_[2], kA_[3])};
    *(u32x2*)(B + KT + (2 * k2 + 1) * T_STRIDE + 8 * w) = (u32x2){cvtpk(kB_[0], kB_[1]), cvtpk(kB_[2], kB_[3])};
    *(u32x2*)(B + VT + (2 * k2) * T_STRIDE + 8 * w) = (u32x2){(I.vv[0] & 0xffffu) | (I.vv[1] << 16), (I.vv[2] & 0xffffu) | (I.vv[3] << 16)};
    *(u32x2*)(B + VT + (2 * k2 + 1) * T_STRIDE + 8 * w) = (u32x2){(I.vv[0] >> 16) | (I.vv[1] & 0xffff0000u), (I.vv[2] >> 16) | (I.vv[3] & 0xffff0000u)};
    if (w == 0) *(f32x2*)(lds + SC0 + (ci & 3) * SC_BYTES + 8 * k2) = (f32x2){__builtin_amdgcn_exp2f(fmaxf(totA, DCLAMP)), __builtin_amdgcn_exp2f(fmaxf(totB, DCLAMP))};
}
__device__ __forceinline__ void scan_ptile(char* lds, int bo, int pso, int w, int l15, int q4) {
    if (w < 4) { const char* B = lds + bo; const int sb = w >> 1, tb = w & 1; f32x4 p = (f32x4){0.f, 0.f, 0.f, 0.f};
        if (sb <= tb) {
#pragma unroll
            for (int ks = 0; ks < 4; ++ks) { const bf16x8 a = *(const bf16x8*)(B + KS + (16 * sb + l15) * QK_STRIDE + 64 * ks + 16 * q4);
                const bf16x8 bq = *(const bf16x8*)(B + QS + (16 * tb + l15) * QK_STRIDE + 64 * ks + 16 * q4);
                p = __builtin_amdgcn_mfma_f32_16x16x32_bf16(a, bq, p, 0, 0, 0); }
            const int t = 16 * tb + l15, s0 = 16 * sb + 4 * q4;
#pragma unroll
            for (int r = 0; r < 4; ++r) p[r] = (s0 + r <= t) ? p[r] : 0.f;
        }
        *(u32x2*)(lds + pso + (16 * tb + l15) * T_STRIDE + (16 * sb + 4 * q4) * 2) = (u32x2){cvtpk(p[0], p[1]), cvtpk(p[2], p[3])}; }
}
template <int MODE = 15> __device__ __forceinline__ void scan_main(f32x4 (&acc)[8], char* lds, int bo, int pso, int sco, const ScanCtx& C, int ci, int w, int l15, int q4) {
    const char* B = lds + bo;
#pragma unroll
    for (int kt = 0; kt < 8; ++kt) acc[kt] = acc[kt] * *(const f32x4*)(lds + sco + (16 * kt + 4 * q4) * 4);
    f32x4 o[2];
#pragma unroll
    for (int tt = 0; tt < 2; ++tt) o[tt] = (f32x4){0.f, 0.f, 0.f, 0.f};
#pragma unroll
    for (int j = 0; j < 4; ++j) {
        const u32x4 bw = (u32x4){cvtpk(acc[2 * j][0], acc[2 * j][1]), cvtpk(acc[2 * j][2], acc[2 * j][3]), cvtpk(acc[2 * j + 1][0], acc[2 * j + 1][1]), cvtpk(acc[2 * j + 1][2], acc[2 * j + 1][3])};
        const bf16x8 bs = __builtin_bit_cast(bf16x8, bw);
#pragma unroll
        for (int tt = 0; tt < 2; ++tt) { const char* row = B + QS + (16 * tt + l15) * QK_STRIDE + (32 * j + 4 * q4) * 2;
            const u32x2 a0 = *(const u32x2*)row, a1 = *(const u32x2*)(row + 32);
            const u32x4 aw = (u32x4){a0.x, a0.y, a1.x, a1.y};
            o[tt] = __builtin_amdgcn_mfma_f32_16x16x32_bf16(__builtin_bit_cast(bf16x8, aw), bs, o[tt], 0, 0, 0); }
    }
    const bf16x8 bv = *(const bf16x8*)(B + VT + (16 * w + l15) * T_STRIDE + 16 * q4);
#pragma unroll
    for (int tt = 0; tt < 2; ++tt) { const bf16x8 ap = *(const bf16x8*)(lds + pso + (16 * tt + l15) * T_STRIDE + 16 * q4);
        o[tt] = __builtin_amdgcn_mfma_f32_16x16x32_bf16(ap, bv, o[tt], 0, 0, 0); }
#pragma unroll
    for (int kt = 0; kt < 8; ++kt) { const bf16x8 ak = *(const bf16x8*)(B + KT + (16 * kt + l15) * T_STRIDE + 16 * q4);
        acc[kt] = __builtin_amdgcn_mfma_f32_16x16x32_bf16(ak, bv, acc[kt], 0, 0, 0); }
    char* os = lds + ((ci & 1) ? OS1 : OS0);
#pragma unroll
    for (int tt = 0; tt < 2; ++tt)
#pragma unroll
        for (int r = 0; r < 4; ++r) *(unsigned short*)(os + (16 * tt + 4 * q4 + r) * OS_STRIDE + (16 * w + l15) * 2) = (unsigned short)(cvtpk(o[tt][r], 0.f) & 0xffffu);
}
__device__ __forceinline__ void scan_flush(char* lds, const ScanCtx& C, int ci, int tid) {
    const int t = tid >> 4, pc = tid & 15;
    const u32x4 v = *(const u32x4*)(lds + ((ci & 1) ? OS1 : OS0) + t * OS_STRIDE + pc * 16);
    const int row0 = tok_row(C.b, C.dir, ci, 0), row = C.dir ? row0 - t : row0 + t;
    *(u32x4*)(C.OUT + (size_t)row * 2048 + C.h * 128 + pc * 8) = v;
}
template <int MODE = 15> __device__ __forceinline__ void scan_seq(const unsigned short* __restrict__ RQ, const unsigned short* __restrict__ RV, const _Float16* __restrict__ LFd, unsigned short* __restrict__ OUT,
                                         int b, int h, int dir, char* lds) {
    int tid_o = threadIdx.x; asm volatile("" : "+v"(tid_o));
    const int tid = tid_o, w = __builtin_amdgcn_readfirstlane(tid >> 6), lane = tid & 63, l15 = lane & 15, q4 = lane >> 4;
    const int k2 = lane;
    ScanCtx C{RQ, RV, LFd, OUT, b, h, dir, w, (unsigned)(2 * k2), {0u, 0u, 0u, 0u}};
#pragma unroll
    for (int r = 0; r < 4; ++r) C.so[r] = (unsigned)((dir ? 15 - (4 * q4 + r) : 4 * q4 + r) * 2048 + l15);
    f32x4 acc[8];
#pragma unroll
    for (int i = 0; i < 8; ++i) acc[i] = (f32x4){0.f, 0.f, 0.f, 0.f};
    if (tid < 128) ((float*)(lds + SC0 + 3 * SC_BYTES))[tid] = 1.0f;
    ChunkIn IA, IB, IC;
    scan_load(IA, C, 0); scan_load(IB, C, 1); scan_load(IC, C, 2);
    scan_cum(IA, lds, 0, w, k2); scan_cum(IB, lds, 1, w, k2); __syncthreads();
    scan_prep(IA, lds, 0, 0, w, k2); scan_prep(IB, lds, BUF_BYTES, 1, w, k2); scan_load(IA, C, 3); scan_load(IB, C, 4); __syncthreads();
    scan_cum(IC, lds, 2, w, k2); scan_ptile(lds, 0, PS0, w, l15, q4); __syncthreads();
#define SCN_PSO(c) (PS0 + ((c) & 1) * PS_BYTES)
#define SCN_SCO(c) (SC0 + (((c) + 3) & 3) * SC_BYTES)
    for (int cp = 0; cp < NCHUNK; cp += 3) {
        if (cp > 0) scan_flush(lds, C, cp - 1, tid);
        if (cp + 3 < NCHUNK) if constexpr (MODE & 4) scan_cum(IA, lds, cp + 3, w, k2);
        if constexpr (MODE & 4) scan_prep(IC, lds, 2 * BUF_BYTES, cp + 2, w, k2); if (cp + 5 < NCHUNK) scan_load(IC, C, cp + 5);
        if constexpr (MODE & 8) scan_ptile(lds, BUF_BYTES, SCN_PSO(cp + 1), w, l15, q4);
        if constexpr (MODE & 2) scan_main<MODE>(acc, lds, 0, SCN_PSO(cp), SCN_SCO(cp), C, cp, w, l15, q4); __syncthreads();
        scan_flush(lds, C, cp, tid);
        if (cp + 4 < NCHUNK) if constexpr (MODE & 4) scan_cum(IB, lds, cp + 4, w, k2);
        if (cp + 3 < NCHUNK) { if constexpr (MODE & 4) scan_prep(IA, lds, 0, cp + 3, w, k2); if (cp + 6 < NCHUNK) scan_load(IA, C, cp + 6); }
        if constexpr (MODE & 8) scan_ptile(lds, 2 * BUF_BYTES, SCN_PSO(cp + 2), w, l15, q4);
        if constexpr (MODE & 2) scan_main<MODE>(acc, lds, BUF_BYTES, SCN_PSO(cp + 1), SCN_SCO(cp + 1), C, cp + 1, w, l15, q4); __syncthreads();
        scan_flush(lds, C, cp + 1, tid);
        if (cp + 5 < NCHUNK) if constexpr (MODE & 4) scan_cum(IC, lds, cp + 5, w, k2);
        if (cp + 4 < NCHUNK) { if constexpr (MODE & 4) scan_prep(IB, lds, BUF_BYTES, cp + 4, w, k2); if (cp + 7 < NCHUNK) scan_load(IB, C, cp + 7); }
        if (cp + 3 < NCHUNK) if constexpr (MODE & 8) scan_ptile(lds, 0, SCN_PSO(cp + 3), w, l15, q4);
        if constexpr (MODE & 2) scan_main<MODE>(acc, lds, 2 * BUF_BYTES, SCN_PSO(cp + 2), SCN_SCO(cp + 2), C, cp + 2, w, l15, q4); __syncthreads();
    }
    scan_flush(lds, C, NCHUNK - 1, tid);
#undef SCN_PSO
#undef SCN_SCO
}
}


constexpr int NWAVES = 8;
constexpr int DM = 2048, NBATCH = 8, SEQ = 2048, CTXL = 256, DEPTH = 4;
constexpr int ML = NBATCH * SEQ, MC = NBATCH * CTXL, MT = ML + MC;
constexpr int NQKV = 3072, NREC = 10240, DFF = 8192, NMOD = 12288;
constexpr float NORM_EPS = 1e-6f;
constexpr int N_PHASES = 3 + 8 * DEPTH;

constexpr size_t MiB = 1u << 20;
constexpr size_t WS_CTL = 0, CTL_ZERO_BYTES = 1 * MiB;
constexpr size_t WS_MOD = 1 * MiB;
constexpr size_t WS_TAB = 4 * MiB;
constexpr size_t TAB_COS = 0, TAB_SIN = 8192, TAB_LB = 16384;
constexpr size_t WS_WQKV = 8 * MiB, WS_WAO = 32 * MiB, WS_WRI = 48 * MiB, WS_WRO = 128 * MiB, WS_WUP = 144 * MiB, WS_WDN = 272 * MiB;
constexpr size_t WS_X = 400 * MiB;
constexpr size_t WS_H = 544 * MiB;
constexpr size_t WS_O = 616 * MiB;
constexpr size_t WS_U = 688 * MiB;
constexpr size_t WS_OF = WS_U, WS_OB = WS_U + 72 * MiB;
constexpr size_t WS_GSLAB = WS_U + 144 * MiB;
constexpr size_t WS_MIX = 976 * MiB;
constexpr size_t WS_RQ = WS_MIX, WS_RV = WS_MIX + 72 * MiB, WS_RG = WS_MIX + 144 * MiB, WS_LF = WS_MIX + 216 * MiB;
constexpr size_t WS_END = WS_MIX + 504 * MiB;
constexpr int CW_TMO = 0, CW_BAR = 4096;

constexpr int RING_BYTES = 131072, LDSCTL_OFF = RING_BYTES, MISC_OFF = LDSCTL_OFF + 320, LDS_BYTES = 156672;

__device__ __forceinline__ float xor_get(float v, int lane, int o) { return __int_as_float(__builtin_amdgcn_ds_bpermute((lane ^ o) << 2, __float_as_int(v))); }
__device__ __forceinline__ float wave_sum(float v, int lane) {
#pragma unroll
    for (int o = 1; o < 64; o <<= 1) v += xor_get(v, lane, o);
    return v;
}

__device__ __forceinline__ int rope_row(int n) {
    if (n >= 2560) return n;
    const int d = n & 127, a = d >> 6, jj = (d >> 5) & 1, i = d & 31;
    return (n & ~127) + a * 64 + (i >> 2) * 8 + jj * 4 + (i & 3);
}
__device__ __forceinline__ void transpose_item(const float* W, int K, int N, bf16* WT, bool perm, LAS float* scr, int item, int lane) {
    const int nblk = N / 32, kb = item / nblk, nb = item % nblk, k0 = 64 * kb, n0 = 32 * nb;
    const float* src = W + (size_t)(k0 + (lane >> 5)) * N + n0 + (lane & 31);
    float v[32];
#pragma unroll
    for (int i = 0; i < 32; ++i) v[i] = src[(size_t)(2 * i) * N];
#pragma unroll
    for (int i = 0; i < 32; ++i) scr[(2 * i + (lane >> 5)) * 33 + (lane & 31)] = v[i];
    LDS_WAIT(); asm volatile("" ::: "memory");
    const int c = lane & 7;
#pragma unroll
    for (int j = 0; j < 4; ++j) { const int n = (lane >> 3) + 8 * j; const LAS float* s = scr + (8 * c) * 33 + n;
        v4u o; o.x = pk2(s[0 * 33], s[1 * 33]); o.y = pk2(s[2 * 33], s[3 * 33]); o.z = pk2(s[4 * 33], s[5 * 33]); o.w = pk2(s[6 * 33], s[7 * 33]);
        const int row = perm ? rope_row(n0 + n) : (n0 + n);
        *(GAS v4u*)(WT + (size_t)row * K + k0 + 8 * c) = o; }
    LDS_WAIT(); asm volatile("" ::: "memory");
}

struct KArgs { const float* in[18]; float* out; unsigned char* ws; int ph_lo, ph_hi; };

__device__ __forceinline__ unsigned long long ld_u64(volatile LAS unsigned* PT, int idx);
__device__ __forceinline__ void p0_prologue(volatile LAS unsigned* PT, LAS unsigned char* lds, int tid, int lane, int wave, int gw, int NGW) {
    unsigned char* ws = (unsigned char*)(GAS unsigned char*)ld_u64(PT, 19);
    LAS float* sc = (LAS float*)lds;
    for (int i = tid; i < 9 * DM; i += NWAVES * 64) { const float x = i < 8 * DM ? ((const float*)(const GAS float*)ld_u64(PT, 1))[i] : ((const float*)(const GAS float*)ld_u64(PT, 3))[i - 8 * DM]; sc[i] = x / (1.0f + __expf(-x)); }
    __syncthreads();
    { float* PART = (float*)(ws + WS_U);
      for (int tk = gw; tk < DEPTH * 48 * 16; tk += NGW) {
          const int i = tk / 768, rem = tk % 768, cg = rem >> 4, ks = rem & 15, col = cg * 256 + 4 * lane;
          const float* W = ((const float*)(const GAS float*)ld_u64(PT, 4)) + (size_t)i * DM * NMOD + (size_t)(ks * 128) * NMOD + col;
          f32x4 acc[9];
#pragma unroll
          for (int r = 0; r < 9; ++r) acc[r] = (f32x4){0.f, 0.f, 0.f, 0.f};
#pragma unroll 2
          for (int k4 = 0; k4 < 32; ++k4) {
              const f32x4 w0 = *(const f32x4*)(W + (size_t)(4 * k4 + 0) * NMOD), w1 = *(const f32x4*)(W + (size_t)(4 * k4 + 1) * NMOD),
                          w2 = *(const f32x4*)(W + (size_t)(4 * k4 + 2) * NMOD), w3 = *(const f32x4*)(W + (size_t)(4 * k4 + 3) * NMOD);
#pragma unroll
              for (int r = 0; r < 9; ++r) { const f32x4 s4 = *(const LAS f32x4*)(sc + r * DM + ks * 128 + 4 * k4);
                  acc[r] = acc[r] + w0 * s4.x + w1 * s4.y + w2 * s4.z + w3 * s4.w; }
          }
#pragma unroll
          for (int r = 0; r < 9; ++r) *(f32x4*)(PART + (((size_t)ks * DEPTH + i) * 9 + r) * NMOD + col) = acc[r];
      } }
    if (blockIdx.x == 0) {
        float* cosT = (float*)(ws + WS_TAB + TAB_COS); float* sinT = (float*)(ws + WS_TAB + TAB_SIN); float* LB = (float*)(ws + WS_TAB + TAB_LB);
        for (int i = tid; i < 64 * 32; i += NWAVES * 64) { const int pos = i >> 5, f = i & 31; const float inv = powf(10000.0f, -(float)f / 32.0f); const float ang = (float)pos * inv;
            float sv, cv; sincosf(ang, &sv, &cv); cosT[i] = cv; sinT[i] = sv; }
        for (int i = tid; i < 2 * DM; i += NWAVES * 64) { const float l0 = ((const float*)(const GAS float*)ld_u64(PT, 13))[i], l1 = ((const float*)(const GAS float*)ld_u64(PT, 13))[2 * DM + i]; const float mx = fmaxf(l0, l1);
            const float e0 = expf(l0 - mx), e1 = expf(l1 - mx), g0 = e0 / (e0 + e1), g1 = e1 / (e0 + e1);
            LB[i] = g0 - g0; LB[2 * DM + i] = (g0 + g1) - g0; }
    }
    __syncthreads();
    LAS float* scr = (LAS float*)(lds + wave * 8448);
    constexpr int I_QKV = (DM / 64) * (NQKV / 32), I_WO = (DM / 64) * (DM / 32), I_UP = (DM / 64) * (DFF / 32), I_DN = (DFF / 64) * (DM / 32);
    constexpr int T0 = 2 * I_QKV, T1 = T0 + 2 * I_WO, T3 = T1, T4 = T3 + 4 * I_UP, T5 = T4 + 4 * I_DN;
    for (int it = gw; it < T5; it += NGW) {
        if (it < T0) { const int l = it / I_QKV, r = it % I_QKV; transpose_item(((const float*)(const GAS float*)ld_u64(PT, 8)) + (size_t)l * DM * NQKV, DM, NQKV, (bf16*)(ws + WS_WQKV) + (size_t)l * NQKV * DM, true, scr, r, lane); }
        else if (it < T1) { const int q = it - T0, l = q / I_WO, r = q % I_WO; transpose_item(((const float*)(const GAS float*)ld_u64(PT, 9)) + (size_t)l * DM * DM, DM, DM, (bf16*)(ws + WS_WAO) + (size_t)l * DM * DM, false, scr, r, lane); }
        else if (it < T4) { const int q = it - T3, l = q / I_UP, r = q % I_UP; transpose_item(((const float*)(const GAS float*)ld_u64(PT, 15)) + (size_t)l * DM * DFF, DM, DFF, (bf16*)(ws + WS_WUP) + (size_t)l * DFF * DM, false, scr, r, lane); }
        else { const int q = it - T4, l = q / I_DN, r = q % I_DN; transpose_item(((const float*)(const GAS float*)ld_u64(PT, 16)) + (size_t)l * DFF * DM, DFF, DM, (bf16*)(ws + WS_WDN) + (size_t)l * DM * DFF, false, scr, r, lane); }
    }
}


__device__ __forceinline__ void mod_reduce_phase(const float* PART, const float* bias, float* MOD, int tid, int bx, int G) {
    constexpr int TOT4 = DEPTH * 9 * NMOD / 4;
    for (int e = bx * (NWAVES * 64) + tid; e < TOT4; e += G * NWAVES * 64) {
        const int i = e / (9 * NMOD / 4), n4 = e % (NMOD / 4);
        f32x4 s = *(const f32x4*)(bias + (size_t)i * NMOD + 4 * n4);
#pragma unroll
        for (int ks = 0; ks < 16; ++ks) s = s + *(const GAS f32x4*)(PART + (size_t)ks * (DEPTH * 9 * NMOD) + 4 * (size_t)e);
        *(GAS f32x4*)(MOD + 4 * (size_t)e) = s;
    }
}
typedef _Float16 f16;
typedef _Float16 f16x8 __attribute__((ext_vector_type(8)));
__device__ __forceinline__ void norm_tail(const float (&v)[4][8], float ss, bf16* Hrow, const float* g, const float* sh, const float* scl, int lane) {
    const float rstd = rsqrtf(wave_sum(ss, lane) * (1.0f / DM) + NORM_EPS);
#pragma unroll
    for (int j = 0; j < 4; ++j) { const int c = 8 * (lane + 64 * j); v4u o;
#pragma unroll
        for (int hh = 0; hh < 2; ++hh) { const f32x4 gg = *(const f32x4*)(g + c + 4 * hh), s1 = *(const f32x4*)(scl + c + 4 * hh), s0 = *(const f32x4*)(sh + c + 4 * hh);
            const f32x4 x4 = (f32x4){v[j][4 * hh], v[j][4 * hh + 1], v[j][4 * hh + 2], v[j][4 * hh + 3]};
            const f32x4 y = ((x4 * rstd) * gg) * (s1 + 1.0f) + s0;
            if (hh == 0) { o.x = pk2(y.x, y.y); o.y = pk2(y.z, y.w); } else { o.z = pk2(y.x, y.y); o.w = pk2(y.z, y.w); } }
        *(GAS v4u*)(Hrow + c) = o; }
}
__device__ __forceinline__ void norm0_phase(const float* xl, const float* xc, f16* X, bf16* H, const float* g, const float* mod_i, int lane, int gw, int NGW) {
    for (int r = gw; r < MT; r += NGW) {
        const float* xr = r < ML ? xl + (size_t)r * DM : xc + (size_t)(r - ML) * DM;
        const int r9 = r < ML ? (r >> 11) : 8;
        const float* sh = mod_i + (size_t)r9 * NMOD; const float* scl = sh + DM;
        float v[4][8]; float ss = 0.f;
#pragma unroll
        for (int j = 0; j < 4; ++j) { const int c = 8 * (lane + 64 * j); const f32x4 a = *(const GAS f32x4*)(xr + c), b = *(const GAS f32x4*)(xr + c + 4); f16x8 h;
#pragma unroll
            for (int e = 0; e < 4; ++e) { v[j][e] = a[e]; v[j][4 + e] = b[e]; h[e] = (f16)a[e]; h[4 + e] = (f16)b[e]; }
            *(GAS f16x8*)(X + (size_t)r * DM + c) = h;
#pragma unroll
            for (int e = 0; e < 8; ++e) ss += v[j][e] * v[j][e]; }
        norm_tail(v, ss, H + (size_t)r * DM, g, sh, scl, lane);
    }
}
__device__ __forceinline__ void norm_phase(f16* X, bf16* H, const float* g, const float* mod_i, int shift_chunk, int nrows, int lane, int gw, int NGW,
                                           const f16* slab = nullptr, const float* gate_ctx = nullptr) {
    for (int r = gw; r < nrows; r += NGW) {
        f16* xr = X + (size_t)r * DM;
        const int r9 = r < ML ? (r >> 11) : 8;
        const float* sh = mod_i + (size_t)r9 * NMOD + shift_chunk * DM; const float* scl = sh + DM;
        float v[4][8]; float ss = 0.f;
        const bool fold = (slab != nullptr) && (r >= ML);
#pragma unroll
        for (int j = 0; j < 4; ++j) { const int c = 8 * (lane + 64 * j); const f16x8 xv = *(const GAS f16x8*)(xr + c);
#pragma unroll
            for (int e = 0; e < 8; ++e) v[j][e] = (float)xv[e];
            if (fold) { constexpr size_t PS_ = (size_t)MC * DM; f16x8 h;
                const size_t po = (size_t)(r - ML) * DM + c;
                const f16x8 p0 = *(const GAS f16x8*)(slab + po), p1 = *(const GAS f16x8*)(slab + PS_ + po), p2 = *(const GAS f16x8*)(slab + 2 * PS_ + po), p3 = *(const GAS f16x8*)(slab + 3 * PS_ + po);
                const f32x4 gc0 = *(const f32x4*)(gate_ctx + c), gc1 = *(const f32x4*)(gate_ctx + c + 4);
#pragma unroll
                for (int e = 0; e < 8; ++e) { const float p = (((float)p0[e] + (float)p1[e]) + (float)p2[e]) + (float)p3[e]; v[j][e] += (e < 4 ? gc0[e & 3] : gc1[e & 3]) * p; h[e] = (f16)v[j][e]; }
                *(GAS f16x8*)(xr + c) = h; }
#pragma unroll
            for (int e = 0; e < 8; ++e) ss += v[j][e] * v[j][e]; }
        norm_tail(v, ss, H + (size_t)r * DM, g, sh, scl, lane);
    }
}
__device__ __forceinline__ void readout_phase(const bf16* OF, const bf16* OB, const bf16* RG, const f16* gslab, const float* og, bf16* O, int nrows, int lane, int gw, int NGW) {
    const f32x4 g4 = *(const f32x4*)(og + ((4 * lane) & 127));
    typedef _Float16 f16x4 __attribute__((ext_vector_type(4)));
    for (int r = gw; r < nrows; r += NGW) {
#pragma unroll
        for (int j = 0; j < 8; ++j) { const size_t off = (size_t)r * DM + 4 * (lane + 64 * j);
            const unsigned long long f8 = *(const GAS unsigned long long*)(OF + off), b8 = *(const GAS unsigned long long*)(OB + off);
            f32x4 gr;
            if (r < ML) { const unsigned long long gw8 = *(const GAS unsigned long long*)(RG + off); const unsigned glo = (unsigned)gw8, ghi = (unsigned)(gw8 >> 32);
                gr = (f32x4){__uint_as_float(glo << 16), __uint_as_float(glo & 0xffff0000u), __uint_as_float(ghi << 16), __uint_as_float(ghi & 0xffff0000u)}; }
            else { const size_t po = (size_t)(r - ML) * DM + 4 * (lane + 64 * j); constexpr size_t PS_ = (size_t)MC * DM;
                const f16x4 p0 = *(const GAS f16x4*)(gslab + po), p1 = *(const GAS f16x4*)(gslab + PS_ + po), p2 = *(const GAS f16x4*)(gslab + 2 * PS_ + po), p3 = *(const GAS f16x4*)(gslab + 3 * PS_ + po);
#pragma unroll
                for (int e = 0; e < 4; ++e) gr[e] = (((float)p0[e] + (float)p1[e]) + (float)p2[e]) + (float)p3[e]; }
            const unsigned flo = (unsigned)f8, fhi = (unsigned)(f8 >> 32), blo = (unsigned)b8, bhi = (unsigned)(b8 >> 32);
            f32x4 s; s.x = __uint_as_float(flo << 16) + __uint_as_float(blo << 16); s.y = __uint_as_float(flo & 0xffff0000u) + __uint_as_float(blo & 0xffff0000u);
            s.z = __uint_as_float(fhi << 16) + __uint_as_float(bhi << 16); s.w = __uint_as_float(fhi & 0xffff0000u) + __uint_as_float(bhi & 0xffff0000u);
            float ss = (s.x * s.x + s.y * s.y) + (s.z * s.z + s.w * s.w);
#pragma unroll
            for (int o = 1; o < 32; o <<= 1) ss += xor_get(ss, lane, o);
            const float rstd = rsqrtf(ss * (1.0f / 128.0f) + NORM_EPS);
#pragma unroll
            for (int e = 0; e < 4; ++e) gr[e] = gr[e] * __builtin_amdgcn_rcpf(1.0f + __expf(-gr[e]));
            const float y0 = (s.x * rstd) * g4.x * gr.x, y1 = (s.y * rstd) * g4.y * gr.y, y2 = (s.z * rstd) * g4.z * gr.z, y3 = (s.w * rstd) * g4.w * gr.w;
            *(GAS unsigned long long*)(O + off) = (unsigned long long)pk2(y0, y1) | ((unsigned long long)pk2(y2, y3) << 32); }
    }
}
__device__ __forceinline__ void final_norm_phase(const f16* X, const float* g, float* out, int lane, int gw, int NGW) {
    for (int r = gw; r < ML; r += NGW) {
        float v[4][8]; float ss = 0.f;
#pragma unroll
        for (int j = 0; j < 4; ++j) { const f16x8 xv = *(const GAS f16x8*)(X + (size_t)r * DM + 8 * (lane + 64 * j));
#pragma unroll
            for (int e = 0; e < 8; ++e) { v[j][e] = (float)xv[e]; ss += v[j][e] * v[j][e]; } }
        const float rstd = rsqrtf(wave_sum(ss, lane) * (1.0f / DM) + NORM_EPS);
#pragma unroll
        for (int j = 0; j < 4; ++j) { const int c = 8 * (lane + 64 * j);
#pragma unroll
            for (int hh = 0; hh < 2; ++hh) { const f32x4 gg = *(const f32x4*)(g + c + 4 * hh);
                *(GAS f32x4*)(out + (size_t)r * DM + c + 4 * hh) = ((f32x4){v[j][4 * hh], v[j][4 * hh + 1], v[j][4 * hh + 2], v[j][4 * hh + 3]} * rstd) * gg; } }
    }
}

__device__ __forceinline__ unsigned long long ld_u64(volatile LAS unsigned* PT, int idx) {
    const unsigned lo = __builtin_amdgcn_readfirstlane(PT[2 * idx]), hi = __builtin_amdgcn_readfirstlane(PT[2 * idx + 1]);
    return ((unsigned long long)hi << 32) | lo;
}
#define PIN(i) ((const float*)(const GAS float*)ld_u64(PT, (i)))
#define PWS() ((unsigned char*)(GAS unsigned char*)ld_u64(PT, 19))
__global__ void __launch_bounds__(NWAVES * 64, 2) mk_fwd(KArgs args) {
    extern __shared__ __attribute__((aligned(16))) unsigned char lds[];
    LAS unsigned char* L = (LAS unsigned char*)lds;
    volatile LAS unsigned* MISC = (volatile LAS unsigned*)(L + MISC_OFF);
    volatile LAS unsigned* PT = (volatile LAS unsigned*)(L + MISC_OFF + 256);
    const int tid = threadIdx.x;
    for (int u = tid; u < (LDS_BYTES - LDSCTL_OFF) / 4; u += NWAVES * 64) ((LAS unsigned*)(L + LDSCTL_OFF))[u] = 0u;
    __syncthreads();
    if (tid == 0) {
#define PUT(i, p) do { const unsigned long long v_ = (unsigned long long)(p); PT[2 * (i)] = (unsigned)v_; PT[2 * (i) + 1] = (unsigned)(v_ >> 32); } while (0)
        PUT(0, args.in[0]); PUT(1, args.in[1]); PUT(2, args.in[2]); PUT(3, args.in[3]); PUT(4, args.in[4]); PUT(5, args.in[5]); PUT(6, args.in[6]); PUT(7, args.in[7]); PUT(8, args.in[8]);
        PUT(9, args.in[9]); PUT(10, args.in[10]); PUT(11, args.in[11]); PUT(12, args.in[12]); PUT(13, args.in[13]); PUT(14, args.in[14]); PUT(15, args.in[15]); PUT(16, args.in[16]);
        PUT(17, args.in[17]); PUT(18, args.out); PUT(19, args.ws); PT[40] = (unsigned)args.ph_lo; PT[41] = (unsigned)args.ph_hi;
#undef PUT
    }
    __syncthreads();
#define PH_LO() ((int)__builtin_amdgcn_readfirstlane(PT[40]))
#define PH_HI() ((int)__builtin_amdgcn_readfirstlane(PT[41]))
    if (PH_HI() - PH_LO() > 1) (void)xcd_barrier_post((unsigned*)((gu32*)(PWS() + WS_CTL) + CW_BAR), MISC + 8);
#define IN(k) (PH_LO() <= (k) && (k) < PH_HI())
#define SEAM(k) do { if ((k) + 1 < PH_HI()) { XcdBarrier b_; b_.bar = (unsigned*)((gu32*)(PWS() + WS_CTL) + CW_BAR); b_.x = xb_xcc_id(); b_.st = MISC + 8; xcd_barrier(b_); } } while (0)
#define GEO() int tid_g = threadIdx.x; asm volatile("" : "+v"(tid_g)); const int lane = tid_g & 63, wave = __builtin_amdgcn_readfirstlane(tid_g >> 6), G = gridDim.x, bx = blockIdx.x, \
                        vcu = (G % 8 == 0) ? (bx % 8) * (G / 8) + bx / 8 : bx, gw = vcu * NWAVES + wave, NGW = G * NWAVES; (void)lane; (void)gw; (void)NGW

    if (IN(0)) { GEO(); p0_prologue(PT, L, tid_g, lane, wave, gw, NGW); SEAM(0); }
    if (IN(1)) { GEO(); unsigned char* ws = PWS(); mod_reduce_phase((const float*)(ws + WS_U), PIN(5), (float*)(ws + WS_MOD), tid_g, bx, G); SEAM(1); }
    if (IN(2)) { GEO(); unsigned char* ws = PWS(); norm0_phase(PIN(0), PIN(2), (f16*)(ws + WS_X), (bf16*)(ws + WS_H), PIN(6), (const float*)(ws + WS_MOD), lane, gw, NGW); SEAM(2); }

    for (int Lr = 0; Lr < DEPTH; ++Lr) {
        const int pb = 3 + 8 * Lr;
        if ((Lr & 1) == 0) {
            if (IN(pb + 0)) {
                GEO(); unsigned char* ws = PWS(); const int jl = Lr >> 1;
                pg8::Gemm g{(const bf16*)(ws + WS_H), (const bf16*)(ws + WS_WQKV) + (size_t)jl * NQKV * DM, MT, NQKV, DM, DM}; pg8::StaticOrder S; S.init(MT, NQKV, G, bx);
                pg8::EpiQkv E{(bf16*)(ws + WS_MIX), (const float*)(ws + WS_TAB + TAB_COS), (const float*)(ws + WS_TAB + TAB_SIN)};
                pg8::gemm_phase<pg8::EpiQkv, pg8::StaticOrder, true, true>(L, g, S, E);
                { constexpr int NU = (MT / 256) * (NQKV / 256), I_RI = (DM / 64) * (NREC / 32), I_WO = (DM / 64) * (DM / 32);
                  const int first = NU % G, nid = G - first;
                  if (bx >= first) { LAS float* scr = (LAS float*)(L + wave * 8448);
                      for (int it = (bx - first) * NWAVES + wave; it < I_RI + I_WO; it += nid * NWAVES) {
                          if (it < I_RI) transpose_item(PIN(11) + (size_t)jl * DM * NREC, DM, NREC, (bf16*)(ws + WS_WRI) + (size_t)jl * NREC * DM, false, scr, it, lane);
                          else transpose_item(PIN(12) + (size_t)jl * DM * DM, DM, DM, (bf16*)(ws + WS_WRO) + (size_t)jl * DM * DM, false, scr, it - I_RI, lane); } } }
                SEAM(pb + 0);
            }
            if (IN(pb + 1)) {
                GEO(); unsigned char* ws = PWS(); const int jl = Lr >> 1;
                const bf16* QKV = (const bf16*)(ws + WS_MIX); bf16* Ob = (bf16*)(ws + WS_O); const float* sinkp = PIN(10) + jl * 16;
#ifndef REP_ATTN
#define REP_ATTN 1
#endif
                for (int rep_ = 0; rep_ < REP_ATTN; ++rep_) att::attn_units(QKV, Ob, sinkp, bx, G, (char*)lds);
                SEAM(pb + 1);
            }
        } else {
            if (IN(pb + 0)) {
                GEO(); unsigned char* ws = PWS(); const int jl = Lr >> 1;
                const bf16* Wri = (const bf16*)(ws + WS_WRI) + (size_t)jl * NREC * DM;
                pg8::Gemm g{(const bf16*)(ws + WS_H), Wri, MT, NREC, DM, DM}; pg8::RecOrder S; S.init(G, bx);
                pg8::EpiRec E{(bf16*)(ws + WS_RQ), (bf16*)(ws + WS_RV), (bf16*)(ws + WS_RG), (pg8::f16_t*)(ws + WS_LF), (const float*)(ws + WS_TAB + TAB_LB) + jl * 2 * DM, (size_t)MT * DM, jl == 0};
                pg8::gemm_phase<pg8::EpiRec, pg8::RecOrder, true, true>(L, g, S, E);
                if (Lr != DEPTH - 1) { pg8::Gemm g2{(const bf16*)(ws + WS_H), Wri + (size_t)(4 * DM) * DM, MT, DM, DM / 4, DM}; pg8::SplitKCtxOrder S2; S2.init(G, bx, DM / 4);
                    pg8::EpiPart E2{(pg8::f16_t*)(ws + WS_GSLAB), DM / 4};
                    pg8::gemm_phase<pg8::EpiPart, pg8::SplitKCtxOrder, true, true>(L, g2, S2, E2); }
                SEAM(pb + 0);
            }
            if (IN(pb + 1)) {
                GEO(); unsigned char* ws = PWS();
                for (int sid = bx; sid < 256; sid += G) { const int b = sid >> 5, h = (sid >> 1) & 15, dir = sid & 1;
                    scn::scan_seq<15>((const bf16*)(ws + WS_RQ), (const bf16*)(ws + WS_RV), (const f16*)(ws + WS_LF) + (size_t)dir * MT * DM, (bf16*)(ws + (dir ? WS_OB : WS_OF)), b, h, dir, (char*)lds);
                    __syncthreads();
#ifdef PROBE_MODE
                    scn::scan_seq<PROBE_MODE>((const bf16*)(ws + WS_RQ), (const bf16*)(ws + WS_RV), (const f16*)(ws + WS_LF) + (size_t)dir * MT * DM, (bf16*)(ws + (dir ? WS_OB : WS_OF)), b, h, dir, (char*)lds);
                    __syncthreads();
#endif
                }
                SEAM(pb + 1);
            }
            if (IN(pb + 2)) {
                GEO(); unsigned char* ws = PWS(); const int jl = Lr >> 1;
                readout_phase((const bf16*)(ws + WS_OF), (const bf16*)(ws + WS_OB), (const bf16*)(ws + WS_RG), (const f16*)(ws + WS_GSLAB), PIN(14) + jl * 128, (bf16*)(ws + WS_O), Lr == DEPTH - 1 ? ML : MT, lane, gw, NGW);
                SEAM(pb + 2);
            }
        }
        if (IN(pb + 3)) {
            GEO(); unsigned char* ws = PWS(); const int jl = Lr >> 1, Mrows = (Lr == DEPTH - 1) ? ML : MT;
            const bf16* Wt = (Lr & 1) ? (const bf16*)(ws + WS_WRO) + (size_t)jl * DM * DM : (const bf16*)(ws + WS_WAO) + (size_t)jl * DM * DM;
            pg8::Gemm g{(const bf16*)(ws + WS_O), Wt, ML, DM, DM, DM}; pg8::StaticOrder S; S.init(ML, DM, G, bx);
            pg8::EpiRes E{(pg8::f16_t*)(ws + WS_X), (const float*)(ws + WS_MOD) + (size_t)Lr * 9 * NMOD + 2 * DM};
            pg8::gemm_phase<pg8::EpiRes, pg8::StaticOrder, true, true>(L, g, S, E);
            if (Mrows == MT) { pg8::Gemm g2{(const bf16*)(ws + WS_O), Wt, MT, DM, DM / 4, DM}; pg8::SplitKCtxOrder S2; S2.init(G, bx, DM / 4);
                pg8::EpiPart E2{(pg8::f16_t*)(ws + WS_U), DM / 4};
                pg8::gemm_phase<pg8::EpiPart, pg8::SplitKCtxOrder, true, true>(L, g2, S2, E2); }
            SEAM(pb + 3);
        }
        if (IN(pb + 4)) { GEO(); unsigned char* ws = PWS();
            norm_phase((f16*)(ws + WS_X), (bf16*)(ws + WS_H), PIN(7) + Lr * DM, (const float*)(ws + WS_MOD) + (size_t)Lr * 9 * NMOD, 3, (Lr == DEPTH - 1) ? ML : MT, lane, gw, NGW,
                       (const f16*)(ws + WS_U), (const float*)(ws + WS_MOD) + ((size_t)Lr * 9 + 8) * NMOD + 2 * DM); SEAM(pb + 4); }
        if (IN(pb + 5)) {
            GEO(); unsigned char* ws = PWS(); const int Mrows = (Lr == DEPTH - 1) ? ML : MT;
            pg8::Gemm g{(const bf16*)(ws + WS_H), (const bf16*)(ws + WS_WUP) + (size_t)Lr * DFF * DM, Mrows, DFF, DM, DM}; pg8::StaticOrder S; S.init(Mrows, DFF, G, bx);
            pg8::EpiUp E{(bf16*)(ws + WS_U), DFF};
            pg8::gemm_phase<pg8::EpiUp, pg8::StaticOrder, true, true>(L, g, S, E);
            SEAM(pb + 5);
        }
        if (IN(pb + 6)) {
            GEO(); unsigned char* ws = PWS(); const int Mrows = (Lr == DEPTH - 1) ? ML : MT;
            const bf16* Wd = (const bf16*)(ws + WS_WDN) + (size_t)Lr * DM * DFF;
            pg8::Gemm g{(const bf16*)(ws + WS_U), Wd, ML, DM, DFF, DFF}; pg8::StaticOrder S; S.init(ML, DM, G, bx);
            pg8::EpiRes E{(pg8::f16_t*)(ws + WS_X), (const float*)(ws + WS_MOD) + (size_t)Lr * 9 * NMOD + 5 * DM};
            pg8::gemm_phase<pg8::EpiRes, pg8::StaticOrder, true, true>(L, g, S, E);
            if (Mrows == MT) { pg8::Gemm g2{(const bf16*)(ws + WS_U), Wd, MT, DM, DFF / 4, DFF}; pg8::SplitKCtxOrder S2; S2.init(G, bx, DFF / 4);
                pg8::EpiPart E2{(pg8::f16_t*)(ws + WS_O), DFF / 4};
                pg8::gemm_phase<pg8::EpiPart, pg8::SplitKCtxOrder, true, true>(L, g2, S2, E2); }
            SEAM(pb + 6);
        }
        if (IN(pb + 7)) {
            GEO(); unsigned char* ws = PWS(); f16* X = (f16*)(ws + WS_X);
            if (Lr != DEPTH - 1) norm_phase(X, (bf16*)(ws + WS_H), PIN(6) + (Lr + 1) * DM, (const float*)(ws + WS_MOD) + (size_t)(Lr + 1) * 9 * NMOD, 0, MT, lane, gw, NGW,
                                            (const f16*)(ws + WS_O), (const float*)(ws + WS_MOD) + ((size_t)Lr * 9 + 8) * NMOD + 5 * DM);
            else final_norm_phase(X, PIN(17), (float*)(GAS float*)ld_u64(PT, 18), lane, gw, NGW);
            SEAM(pb + 7);
        }
    }
#undef IN
#undef SEAM
#undef GEO
}

#ifndef MK_ONE_LAUNCH
#define MK_ONE_LAUNCH 1
#endif
extern "C" void kernel_launch(void* const* d_in, const int* in_sizes, int n_in, void* d_out, int out_size, void* d_ws, size_t ws_size, hipStream_t stream) {
    static int grid = 0;
    if (grid == 0) {
        if (n_in != 18 || in_sizes[0] != ML * DM || out_size != ML * DM || ws_size < WS_END) {
            fprintf(stderr, "kernel_launch: shape mismatch: n_in %d in0 %d out %d ws %zu (need %zu)\n", n_in, n_in > 0 ? in_sizes[0] : -1, out_size, ws_size, (size_t)WS_END); grid = -1; return; }
        int dev = 0, cus = 0, per_cu = 0;
        if (hipGetDevice(&dev) != hipSuccess || hipDeviceGetAttribute(&cus, hipDeviceAttributeMultiprocessorCount, dev) != hipSuccess) { fprintf(stderr, "kernel_launch: device query failed\n"); grid = -1; return; }
        if (hipFuncSetAttribute((const void*)mk_fwd, hipFuncAttributeMaxDynamicSharedMemorySize, LDS_BYTES) != hipSuccess) { fprintf(stderr, "kernel_launch: hipFuncSetAttribute failed\n"); grid = -1; return; }
        if (hipOccupancyMaxActiveBlocksPerMultiprocessor(&per_cu, (const void*)mk_fwd, NWAVES * 64, LDS_BYTES) != hipSuccess || per_cu < 1)
            fprintf(stderr, "kernel_launch: note: occupancy query reports %d workgroups per CU\n", per_cu);
        (void)hipGetLastError();
        grid = cus;
    }
    if (grid < 0) return;
    if (hipMemsetAsync((char*)d_ws + WS_CTL, 0, CTL_ZERO_BYTES, stream) != hipSuccess) { fprintf(stderr, "kernel_launch: memset failed\n"); return; }
    KArgs a{};
    for (int i = 0; i < 18; ++i) a.in[i] = (const float*)d_in[i];
    a.out = (float*)d_out; a.ws = (unsigned char*)d_ws;
#if MK_ONE_LAUNCH
    a.ph_lo = 0; a.ph_hi = N_PHASES;
    hipLaunchKernelGGL(mk_fwd, dim3(grid), dim3(NWAVES * 64), LDS_BYTES, stream, a);
#else
    for (int ph = 0; ph < N_PHASES; ++ph) {
        if (ph >= 3) { const int Lr = (ph - 3) / 8, s = (ph - 3) % 8; if ((Lr & 1) == 0 && s == 2) continue; }
        a.ph_lo = ph; a.ph_hi = ph + 1;
        hipLaunchKernelGGL(mk_fwd, dim3(grid), dim3(NWAVES * 64), LDS_BYTES, stream, a);
    }
#endif
    const hipError_t le = hipPeekAtLastError();
    if (le != hipSuccess) fprintf(stderr, "kernel_launch: launch failed: %s\n", hipGetErrorName(le));
}
```

```cpp
#include <hip/hip_runtime.h>
#include <cstdio>
#include <cstdint>
#include <cmath>

namespace pg8 {
#define PG8_LAS __attribute__((address_space(3)))
typedef unsigned short bf16_t;
typedef short bf16x8 __attribute__((ext_vector_type(8)));
typedef float f32x4 __attribute__((ext_vector_type(4)));
typedef unsigned u32x4 __attribute__((ext_vector_type(4)));
typedef unsigned u32x2 __attribute__((ext_vector_type(2)));
constexpr int BM = 256, BK = 64, HALF = 128, HTB = HALF * BK * 2  , STAGE_BYTES = 8 * HTB, NXCD = 8, WGM = 4;

__host__ __device__ __forceinline__ int lds_byte(int r, int c) { const int st = (r >> 4) * 2 + (c >> 5), rr = r & 15, cc = c & 31, ob = rr * 64 + cc * 2; return st * 1024 + (ob ^ (((ob >> 9) & 1) << 5)); }
__host__ __device__ __forceinline__ void stage_rc(int b, int& R, int& C) { const int st = b / 1024, sb = b % 1024, swz = sb ^ (((sb >> 9) & 1) << 5); R = (st >> 1) * 16 + swz / 64; C = (st & 1) * 32 + (swz % 64) / 2; }
__host__ __device__ __forceinline__ int perm32(int rho) { const int n = rho >> 4, i = rho & 15; return 8 * (i >> 2) + 4 * n + (i & 3); }

struct Unit { int pm, pn, kofs; };
struct Gemm { const bf16_t* A; const bf16_t* Bt; int M, N, K, ld; };


struct SplitKCtxOrder {
    int G, c, ks;
    __host__ __device__ void init(int G_, int c_, int ks_) { G = G_; c = c_; ks = ks_; }
    __host__ __device__ bool next(int i, Unit& u) const {
        const int idx = i * G + c; if (idx >= 256) return false;
        const int t = idx >> 2; u.pm = 64 + (t >> 3); u.pn = t & 7; u.kofs = (idx & 3) * ks; return true;
    }
    __device__ __forceinline__ void a_ready(const Unit&) const {}
    __device__ __forceinline__ void done(const Unit&) const {}
};
struct StaticOrder {
    int nM, nN, nwg, G, c;
    __host__ __device__ void init(int M, int N, int G_, int c_) { nM = M / BM; nN = N / BM; nwg = nM * nN; G = G_; c = c_; }
    __host__ __device__ bool next(int i, Unit& u) const { return map((long)i * G + c, u); }
    __host__ __device__ bool map(long L, Unit& u) const {
        if (L >= nwg) return false;
        int wgid = (int)L; { const int q = nwg / NXCD, r = nwg % NXCD, xcd = wgid % NXCD, off = wgid / NXCD; wgid = (xcd < r ? xcd * (q + 1) : r * (q + 1) + (xcd - r) * q) + off; }
        const int nig = WGM * nN, gid = wgid / nig, fm = gid * WGM, gsz = (nM - fm) < WGM ? (nM - fm) : WGM;
        u.pm = fm + ((wgid % nig) % gsz); u.pn = (wgid % nig) / gsz; u.kofs = 0; return true;
    }
    __device__ __forceinline__ void a_ready(const Unit&) const {}
    __device__ __forceinline__ void done(const Unit&) const {}
};
struct RecOrder {
    StaticOrder lat, ctx; int G, c;
    __host__ __device__ void init(int G_, int c_) { G = G_; c = c_; lat.init(16384, 10240, G_, c_); ctx.init(2048, 8192, G_, c_); }
    __host__ __device__ bool next(int i, Unit& u) const {
        long L = (long)i * G + c; if (L < lat.nwg) return lat.map(L, u);
        L -= lat.nwg; if (!ctx.map(L, u)) return false;
        u.pm += 64; return true;
    }
    __device__ __forceinline__ void a_ready(const Unit&) const {}
    __device__ __forceinline__ void done(const Unit&) const {}
};


__device__ __forceinline__ unsigned cvt_pk_bf16(float lo, float hi) { unsigned r; asm volatile("v_cvt_pk_bf16_f32 %0, %1, %2" : "=v"(r) : "v"(lo), "v"(hi)); return r; }
__device__ __forceinline__ float fast_sigmoid(float x) { return __builtin_amdgcn_rcpf(1.0f + __expf(-x)); }
__device__ __forceinline__ float fast_silu(float x) { return x * fast_sigmoid(x); }

constexpr int E_ML = 16384;
constexpr int E_DM = 2048, E_NMOD = 12288;

typedef _Float16 f16_t;
typedef _Float16 f16x8 __attribute__((ext_vector_type(8)));
struct EpiRes {
    static constexpr bool PERM = true, AFTER_DRAIN = false;
    f16_t* X; const float* gate;
    __device__ __forceinline__ void operator()(const f32x4 (&acc)[2][2][4][2], const Unit& u, int wr, int wc, int fr, int fq) const {
        const int row0 = u.pm * BM + wr * 64 + fr, col0 = u.pn * BM + wc * 32 + 8 * fq;
        const int r9 = (u.pm < (E_ML / BM)) ? (u.pm >> 3) : 8;
        const float* gp = gate + (size_t)r9 * E_NMOD + col0;
        f32x4 gv[2][2];
#pragma unroll
        for (int bj = 0; bj < 2; ++bj)
#pragma unroll
            for (int n = 0; n < 2; ++n) gv[bj][n] = *(const f32x4*)(gp + bj * HALF + 4 * n);
        f16_t* xp = X + (size_t)row0 * E_DM + col0;
#pragma unroll
        for (int ai = 0; ai < 2; ++ai) {
            f16x8 xv[4][2];
#pragma unroll
            for (int m = 0; m < 4; ++m)
#pragma unroll
                for (int bj = 0; bj < 2; ++bj) xv[m][bj] = *(const f16x8*)(xp + (size_t)(ai * HALF + m * 16) * E_DM + bj * HALF);
#pragma unroll
            for (int m = 0; m < 4; ++m)
#pragma unroll
                for (int bj = 0; bj < 2; ++bj) { f16x8 r;
#pragma unroll
                    for (int j = 0; j < 4; ++j) { r[j] = (f16_t)((float)xv[m][bj][j] + gv[bj][0][j] * acc[ai][bj][m][0][j]); r[4 + j] = (f16_t)((float)xv[m][bj][4 + j] + gv[bj][1][j] * acc[ai][bj][m][1][j]); }
                    *(f16x8*)(xp + (size_t)(ai * HALF + m * 16) * E_DM + bj * HALF) = r; }
            asm volatile("" ::: "memory"); }
    }
};
struct EpiUp {
    static constexpr bool PERM = true, AFTER_DRAIN = false;
    bf16_t* O; int ldc;
    __device__ __forceinline__ void operator()(const f32x4 (&acc)[2][2][4][2], const Unit& u, int wr, int wc, int fr, int fq) const {
        const int row0 = u.pm * BM + wr * 64 + fr, col0 = u.pn * BM + wc * 32 + 8 * fq;
#pragma unroll
        for (int ai = 0; ai < 2; ++ai)
#pragma unroll
            for (int m = 0; m < 4; ++m) { bf16_t* rowp = O + (size_t)(row0 + ai * HALF + m * 16) * ldc + col0;
#pragma unroll
                for (int bj = 0; bj < 2; ++bj) { f32x4 v0 = acc[ai][bj][m][0], v1 = acc[ai][bj][m][1], m0, m1;
#pragma unroll
                    for (int j = 0; j < 4; ++j) { asm("v_max_f32 %0, 0, %1" : "=v"(m0[j]) : "v"(v0[j])); asm("v_max_f32 %0, 0, %1" : "=v"(m1[j]) : "v"(v1[j])); }
                    v0 = v0 * m0; v1 = v1 * m1;
                    u32x4 w; w.x = cvt_pk_bf16(v0[0], v0[1]); w.y = cvt_pk_bf16(v0[2], v0[3]); w.z = cvt_pk_bf16(v1[0], v1[1]); w.w = cvt_pk_bf16(v1[2], v1[3]);
                    *(u32x4*)(rowp + bj * HALF) = w; } }
    }
};
struct EpiQkv {
    static constexpr bool PERM = true, AFTER_DRAIN = false;
    bf16_t* O; const float* cosT; const float* sinT;
    __device__ __forceinline__ void operator()(const f32x4 (&acc)[2][2][4][2], const Unit& u, int wr, int wc, int fr, int fq) const {
        const int row0 = u.pm * BM + wr * 64 + fr, col0 = u.pn * BM + wc * 32 + 8 * fq;
        const bool rope = (u.pn < 10) && (u.pm < (E_ML / BM));
        const int axis = wc >> 1, i0 = ((wc & 1) * 4 + fq) * 4;
#pragma unroll
        for (int ai = 0; ai < 2; ++ai)
#pragma unroll
            for (int m = 0; m < 4; ++m) { const int row = row0 + ai * HALF + m * 16; bf16_t* rowp = O + (size_t)row * 3072 + col0;
                f32x4 c4 = (f32x4){1.f, 1.f, 1.f, 1.f}, s4 = (f32x4){0.f, 0.f, 0.f, 0.f};
                if (rope) { const int t = row & 2047; const int pos = axis ? (t & 63) : (t >> 6); c4 = *(const f32x4*)(cosT + pos * 32 + i0); s4 = *(const f32x4*)(sinT + pos * 32 + i0); }
#pragma unroll
                for (int bj = 0; bj < 2; ++bj) { const f32x4 v0 = acc[ai][bj][m][0], v1 = acc[ai][bj][m][1];
                    const f32x4 o0 = v0 * c4 - v1 * s4, o1 = v1 * c4 + v0 * s4;
                    u32x4 w; w.x = cvt_pk_bf16(o0[0], o0[1]); w.y = cvt_pk_bf16(o0[2], o0[3]); w.z = cvt_pk_bf16(o1[0], o1[1]); w.w = cvt_pk_bf16(o1[2], o1[3]);
                    *(u32x4*)(rowp + bj * HALF) = w; } }
    }
};
struct EpiRec {
    static constexpr bool PERM = true, AFTER_DRAIN = false;
    bf16_t* RQ; bf16_t* RV; bf16_t* RG; f16_t* LF; const float* LB; size_t lf_stride; bool lb_zero;
    __device__ __forceinline__ void operator()(const f32x4 (&acc)[2][2][4][2], const Unit& u, int wr, int wc, int fr, int fq) const {
        const int seg = u.pn >> 3;
        const int row0 = u.pm * BM + wr * 64 + fr, col0 = (u.pn & 7) * BM + wc * 32 + 8 * fq;
        if (seg == 2 || seg == 3) {
            const int dir = seg - 2; f16_t* base = LF + (size_t)dir * lf_stride;
            f32x4 lb[2][2];
#pragma unroll
            for (int bj = 0; bj < 2; ++bj)
#pragma unroll
                for (int n = 0; n < 2; ++n) lb[bj][n] = *(const f32x4*)(LB + dir * E_DM + col0 + bj * HALF + 4 * n);
#define EPIREC_F_LOOP(EXPR) _Pragma("unroll") for (int ai = 0; ai < 2; ++ai) _Pragma("unroll") for (int m = 0; m < 4; ++m) { f16_t* rowp = base + (size_t)(row0 + ai * HALF + m * 16) * E_DM + col0; \
                _Pragma("unroll") for (int bj = 0; bj < 2; ++bj) { f16x8 o; \
                    _Pragma("unroll") for (int n = 0; n < 2; ++n) { const f32x4 z = acc[ai][bj][m][n]; \
                        _Pragma("unroll") for (int j = 0; j < 4; ++j) { const float zc = fmaxf(z[j], -80.f); const float l = lb[bj][n][j]; (void)l; o[4 * n + j] = (f16_t)(EXPR); } } \
                    *(f16x8*)(rowp + bj * HALF) = o; } }
            if (lb_zero) { EPIREC_F_LOOP(-__builtin_amdgcn_logf(1.0f + __expf(-zc))) }
            else { EPIREC_F_LOOP(__builtin_amdgcn_logf(l + (1.0f - l) * fast_sigmoid(zc))) }
#undef EPIREC_F_LOOP
        } else {
            bf16_t* O = RQ + (size_t)(seg == 4 ? 2 : seg) * ((size_t)72 << 19);
            const bool act = seg == 0;
#pragma unroll
            for (int ai = 0; ai < 2; ++ai)
#pragma unroll
                for (int m = 0; m < 4; ++m) { bf16_t* rowp = O + (size_t)(row0 + ai * HALF + m * 16) * E_DM + col0;
#pragma unroll
                    for (int bj = 0; bj < 2; ++bj) { f32x4 v0 = acc[ai][bj][m][0], v1 = acc[ai][bj][m][1];
                        if (act) {
#pragma unroll
                            for (int j = 0; j < 4; ++j) { v0[j] = fast_silu(v0[j]); v1[j] = fast_silu(v1[j]); } }
                        u32x4 w; w.x = cvt_pk_bf16(v0[0], v0[1]); w.y = cvt_pk_bf16(v0[2], v0[3]); w.z = cvt_pk_bf16(v1[0], v1[1]); w.w = cvt_pk_bf16(v1[2], v1[3]);
                        *(u32x4*)(rowp + bj * HALF) = w; } }
        }
    }
};


struct EpiPart {
    static constexpr bool PERM = true, AFTER_DRAIN = false;
    f16_t* slab; int ks;
    __device__ __forceinline__ void operator()(const f32x4 (&acc)[2][2][4][2], const Unit& u, int wr, int wc, int fr, int fq) const {
        const int s = u.kofs / ks;
        const int row0 = (u.pm - E_ML / BM) * BM + wr * 64 + fr, col0 = u.pn * BM + wc * 32 + 8 * fq;
        f16_t* op = slab + ((size_t)s * 2048 + row0) * E_DM + col0;
#pragma unroll
        for (int ai = 0; ai < 2; ++ai)
#pragma unroll
            for (int m = 0; m < 4; ++m)
#pragma unroll
                for (int bj = 0; bj < 2; ++bj) { f16x8 r;
#pragma unroll
                    for (int j = 0; j < 4; ++j) { r[j] = (f16_t)acc[ai][bj][m][0][j]; r[4 + j] = (f16_t)acc[ai][bj][m][1][j]; }
                    *(f16x8*)(op + (size_t)(ai * HALF + m * 16) * E_DM + bj * HALF) = r; }
    }
};

template <class Epi, class Sched, bool ALIGN_EPI = false, bool SP2 = false>
__device__ __forceinline__ void gemm_phase(PG8_LAS unsigned char* lds, const Gemm g, const Sched& S, const Epi& E) {
    int tid_o = threadIdx.x; asm volatile("" : "+v"(tid_o));
    const int tid = tid_o, wid = __builtin_amdgcn_readfirstlane(tid >> 6), lane = tid & 63, wr = wid >> 2, wc = wid & 3, fr = lane & 15, fq = lane >> 4;
    const int K = g.K, nt = K / BK, LD = g.ld;
    unsigned voffA[2], voffB[2];
#pragma unroll
    for (int i = 0; i < 2; ++i) { int R, C; stage_rc(tid * 16 + i * 8192, R, C); const int Rb = Epi::PERM ? ((R & ~31) + perm32(R & 31)) : R;
        voffA[i] = (unsigned)(R * LD + C) * 2u; voffB[i] = (unsigned)(Rb * LD + C) * 2u; }
    const size_t kstep = (size_t)(BK * 2);
    const size_t hstep = (size_t)HALF * LD * 2;
    const size_t tstep = 2 * hstep;
    const unsigned ldsw = (unsigned)wid * 1024u;
    const int aoff = lds_byte(wr * 64 + fr, fq * 8), boff = lds_byte(wc * 32 + fr, fq * 8);
#define PG8_SA(b, h) (((b) * 2 + (h)) * HTB)
#define PG8_SB(b, h) ((4 + (b) * 2 + (h)) * HTB)
#define PG8_STAGE(bufoff, gbase, voff) do { _Pragma("unroll") for (int _i = 0; _i < 2; ++_i) \
        __builtin_amdgcn_global_load_lds((const unsigned*)((const char*)(gbase) + (voff)[_i]), (PG8_LAS unsigned*)(lds + (bufoff) + ldsw + _i * 8192), 16, 0, 0); } while (0)
#define PG8_LDA(dst, b, h) do { _Pragma("unroll") for (int m = 0; m < 4; ++m) _Pragma("unroll") for (int k = 0; k < 2; ++k) dst[m][k] = *(const PG8_LAS bf16x8*)(lds + PG8_SA(b, h) + aoff + m * 2048 + k * 1024); } while (0)
#define PG8_LDB(dst, b, h) do { _Pragma("unroll") for (int n = 0; n < 2; ++n) _Pragma("unroll") for (int k = 0; k < 2; ++k) dst[n][k] = *(const PG8_LAS bf16x8*)(lds + PG8_SB(b, h) + boff + n * 2048 + k * 1024); } while (0)
#define PG8_MMA4(ai, bj, At, Bt, m, na, nb) \
        asm volatile("v_mfma_f32_16x16x32_bf16 %0, %4, %2, %0\n\tv_mfma_f32_16x16x32_bf16 %0, %5, %3, %0\n\tv_mfma_f32_16x16x32_bf16 %1, %7, %3, %1\n\tv_mfma_f32_16x16x32_bf16 %1, %6, %2, %1" \
            : "+v"(acc[ai][bj][m][na]), "+v"(acc[ai][bj][m][nb]) : "v"(At[m][0]), "v"(At[m][1]), "v"(Bt[na][0]), "v"(Bt[na][1]), "v"(Bt[nb][0]), "v"(Bt[nb][1]))
#define PG8_MMA(ai, bj, At, Bt) do { __builtin_amdgcn_s_setprio(1); PG8_MMA4(ai, bj, At, Bt, 0, 0, 1); PG8_MMA4(ai, bj, At, Bt, 1, 1, 0); PG8_MMA4(ai, bj, At, Bt, 2, 0, 1); PG8_MMA4(ai, bj, At, Bt, 3, 1, 0); \
        __builtin_amdgcn_s_setprio(0); } while (0)
#define PG8_MMAZ(ai, bj, At, Bt) do { __builtin_amdgcn_s_setprio(1); _Pragma("unroll") for (int m = 0; m < 4; ++m) _Pragma("unroll") for (int n = 0; n < 2; ++n) \
        asm volatile("v_mfma_f32_16x16x32_bf16 %0, %1, %2, 0\n\tv_mfma_f32_16x16x32_bf16 %0, %3, %4, %0" : "+v"(acc[ai][bj][m][n]) : "v"(Bt[n][0]), "v"(At[m][0]), "v"(Bt[n][1]), "v"(At[m][1])); \
        __builtin_amdgcn_s_setprio(0); } while (0)
#define PG8_WAIT_V(n) asm volatile("s_waitcnt vmcnt(" #n ")" ::: "memory")
#define PG8_WAIT_L(n) asm volatile("s_waitcnt lgkmcnt(" #n ")" ::: "memory")
#define PG8_BAR __builtin_amdgcn_s_barrier()
#define PG8_SCHED __builtin_amdgcn_sched_barrier(0)
    Unit cur, nxt; int ui = 0;
    if (!S.next(0, cur)) return;
    f32x4 acc[2][2][4][2];
    {
#pragma unroll
    for (int a = 0; a < 2; ++a)
#pragma unroll
        for (int b = 0; b < 2; ++b)
#pragma unroll
            for (int m = 0; m < 4; ++m)
#pragma unroll
                for (int n = 0; n < 2; ++n) acc[a][b][m][n] = (f32x4){0.f, 0.f, 0.f, 0.f};
    }
    bf16x8 At[4][2], B0[2][2], B1[2][2];
    const char* cA = (const char*)g.A + (size_t)cur.pm * tstep + (size_t)cur.kofs * 2; const char* cB = (const char*)g.Bt + (size_t)cur.pn * tstep + (size_t)cur.kofs * 2;
    S.a_ready(cur);
    if constexpr (SP2) {
        PG8_STAGE(PG8_SB(0, 0), cB, voffB); PG8_STAGE(PG8_SB(0, 1), cB + hstep, voffB); PG8_STAGE(PG8_SA(0, 0), cA, voffA); PG8_STAGE(PG8_SA(0, 1), cA + hstep, voffA);
        if (wr == 1) PG8_BAR;
        PG8_WAIT_V(2); PG8_BAR;
        PG8_STAGE(PG8_SB(1, 0), cB + kstep, voffB); PG8_STAGE(PG8_SA(1, 0), cA + kstep, voffA); PG8_STAGE(PG8_SB(1, 1), cB + hstep + kstep, voffB);
        PG8_WAIT_V(6); PG8_BAR;
    } else {
        PG8_STAGE(PG8_SB(0, 0), cB, voffB); PG8_STAGE(PG8_SA(0, 0), cA, voffA); PG8_STAGE(PG8_SB(0, 1), cB + hstep, voffB); PG8_STAGE(PG8_SA(0, 1), cA + hstep, voffA);
        if (wr == 1) PG8_BAR;
        PG8_WAIT_V(4); PG8_BAR;
        PG8_STAGE(PG8_SB(1, 0), cB + kstep, voffB); PG8_STAGE(PG8_SA(1, 0), cA + kstep, voffA); PG8_STAGE(PG8_SB(1, 1), cB + hstep + kstep, voffB);
        PG8_WAIT_V(6); PG8_BAR;
    }
    for (;;) {
        const bool has_next = S.next(ui + 1, nxt);
        const char* nA = has_next ? (const char*)g.A + (size_t)nxt.pm * tstep + (size_t)nxt.kofs * 2 : cA; const char* nB = has_next ? (const char*)g.Bt + (size_t)nxt.pn * tstep + (size_t)nxt.kofs * 2 : cB;
#define PG8_KSETUP(t) const bool last = ((t) == nt - 2); \
            const char* a1 = cA + (size_t)((t) + 1) * kstep;                                           \
            const char* a2 = last ? nA : cA + (size_t)((t) + 2) * kstep; const char* b2 = last ? nB : cB + (size_t)((t) + 2) * kstep;     \
            const char* a3 = a2 + kstep; const char* b3 = b2 + kstep;                                \
            if (last && has_next) S.a_ready(nxt);
#define PG8_KBODY(MF) \
            PG8_LDB(B0, 0, 0); PG8_LDB(B1, 0, 1); PG8_SCHED; PG8_LDA(At, 0, 0); PG8_STAGE(PG8_SA(1, 1), a1 + hstep, voffA); \
            PG8_WAIT_V(8); PG8_WAIT_L(0); PG8_BAR; MF(0, 0, At, B0); MF(0, 1, At, B1); PG8_BAR; PG8_SCHED; \
            PG8_LDA(At, 0, 1); PG8_STAGE(PG8_SB(0, 0), b2, voffB); PG8_STAGE(PG8_SB(0, 1), b2 + hstep, voffB); PG8_STAGE(PG8_SA(0, 0), a2, voffA); \
            PG8_WAIT_V(8); PG8_WAIT_L(0); PG8_BAR; MF(1, 0, At, B0); MF(1, 1, At, B1); PG8_BAR; PG8_SCHED; \
            PG8_LDB(B0, 1, 0); PG8_LDB(B1, 1, 1); PG8_SCHED; PG8_LDA(At, 1, 0); PG8_STAGE(PG8_SA(0, 1), a2 + hstep, voffA); \
            PG8_WAIT_V(8); PG8_WAIT_L(0); PG8_BAR; PG8_MMA(0, 0, At, B0); PG8_MMA(0, 1, At, B1); PG8_BAR; PG8_SCHED; \
            PG8_LDA(At, 1, 1); PG8_STAGE(PG8_SB(1, 0), b3, voffB); PG8_STAGE(PG8_SB(1, 1), b3 + hstep, voffB); PG8_STAGE(PG8_SA(1, 0), a3, voffA); \
            PG8_WAIT_V(8); PG8_WAIT_L(0); PG8_BAR; PG8_MMA(1, 0, At, B0); PG8_MMA(1, 1, At, B1); PG8_BAR; PG8_SCHED;
        if constexpr (SP2) {
            { PG8_KSETUP(0) PG8_KBODY(PG8_MMAZ) }
            for (int t = 2; t < nt; t += 2) { PG8_KSETUP(t) PG8_KBODY(PG8_MMA) }
        } else
        for (int t = 0; t < nt; t += 2) {
            const bool last = (t == nt - 2);
            const char* a1 = cA + (size_t)(t + 1) * kstep;
            const char* a2 = last ? nA : cA + (size_t)(t + 2) * kstep; const char* b2 = last ? nB : cB + (size_t)(t + 2) * kstep;
            const char* a3 = a2 + kstep; const char* b3 = b2 + kstep;
            if (last && has_next) S.a_ready(nxt);
            {
            PG8_LDB(B0, 0, 0); PG8_SCHED; PG8_LDA(At, 0, 0); PG8_STAGE(PG8_SA(1, 1), a1 + hstep, voffA);
            PG8_WAIT_L(8); PG8_BAR; PG8_WAIT_L(0); PG8_MMA(0, 0, At, B0); PG8_BAR; PG8_SCHED;
            PG8_LDB(B1, 0, 1); PG8_STAGE(PG8_SB(0, 0), b2, voffB);
            PG8_BAR; PG8_WAIT_L(0); PG8_MMA(0, 1, At, B1); PG8_BAR;
            PG8_LDA(At, 0, 1); PG8_STAGE(PG8_SA(0, 0), a2, voffA);
            PG8_BAR; PG8_WAIT_L(0); PG8_MMA(1, 0, At, B0); PG8_BAR; PG8_SCHED;
            PG8_STAGE(PG8_SB(0, 1), b2 + hstep, voffB);
            PG8_WAIT_V(6); PG8_BAR; PG8_MMA(1, 1, At, B1); PG8_BAR;
            PG8_LDB(B0, 1, 0); PG8_SCHED; PG8_LDA(At, 1, 0); PG8_STAGE(PG8_SA(0, 1), a2 + hstep, voffA);
            PG8_WAIT_L(8); PG8_BAR; PG8_WAIT_L(0); PG8_MMA(0, 0, At, B0); PG8_BAR; PG8_SCHED;
            PG8_LDB(B1, 1, 1); PG8_STAGE(PG8_SB(1, 0), b3, voffB);
            PG8_BAR; PG8_WAIT_L(0); PG8_MMA(0, 1, At, B1); PG8_BAR;
            PG8_LDA(At, 1, 1); PG8_STAGE(PG8_SA(1, 0), a3, voffA);
            PG8_BAR; PG8_WAIT_L(0); PG8_MMA(1, 0, At, B0); PG8_BAR; PG8_SCHED;
            PG8_STAGE(PG8_SB(1, 1), b3 + hstep, voffB);
            PG8_WAIT_V(6); PG8_BAR; PG8_MMA(1, 1, At, B1); PG8_BAR;
            }
        }
        if constexpr (ALIGN_EPI) { if (wr == 0) PG8_BAR; }
        if constexpr (!Epi::AFTER_DRAIN) { E(acc, cur, wr, wc, fr, fq); S.done(cur); }
        if (!has_next) break;
        if constexpr (!SP2) {
#pragma unroll
        for (int a = 0; a < 2; ++a)
#pragma unroll
            for (int b = 0; b < 2; ++b)
#pragma unroll
                for (int m = 0; m < 4; ++m)
#pragma unroll
                    for (int n = 0; n < 2; ++n) acc[a][b][m][n] = (f32x4){0.f, 0.f, 0.f, 0.f};
        }
        cur = nxt; cA = nA; cB = nB; ++ui;
        if constexpr (ALIGN_EPI) { if (wr == 1) PG8_BAR; }
    }
    PG8_WAIT_V(0);
    if constexpr (!ALIGN_EPI) { if (wr == 0) PG8_BAR; }
    PG8_BAR;
    if constexpr (Epi::AFTER_DRAIN) { E.fused(acc, cur, wr, wc, fr, fq, lds, wid, lane); S.done(cur); }
#undef PG8_SA
#undef PG8_SB
#undef PG8_STAGE
#undef PG8_LDA
#undef PG8_LDB
#undef PG8_MMA
#undef PG8_MMA4
#undef PG8_MMAZ
#undef PG8_KSETUP
#undef PG8_KBODY
#undef PG8_WAIT_V
#undef PG8_WAIT_L
#undef PG8_BAR
#undef PG8_SCHED
}
}

#define GAS __attribute__((address_space(1)))
#define LAS __attribute__((address_space(3)))
typedef unsigned short bf16;
typedef unsigned v4u __attribute__((ext_vector_type(4)));
typedef float f32x4 __attribute__((ext_vector_type(4)));
typedef short bf16x8 __attribute__((ext_vector_type(8)));
typedef GAS unsigned gu32;
typedef GAS unsigned long long gu64;
#define RLX_AGENT __ATOMIC_RELAXED, __HIP_MEMORY_SCOPE_AGENT
#define LDS_WAIT() asm volatile("s_waitcnt lgkmcnt(0)" ::: "memory")
#define VM_WAIT() asm volatile("s_waitcnt vmcnt(0)" ::: "memory")
__device__ __forceinline__ unsigned long long rt() { return __builtin_amdgcn_s_memrealtime(); }
__device__ __forceinline__ unsigned f2bf(float f) { unsigned u = __builtin_bit_cast(unsigned, f); return (u + 0x7fffu + ((u >> 16) & 1u)) >> 16; }
__device__ __forceinline__ unsigned pk2(float lo, float hi) { return f2bf(lo) | (f2bf(hi) << 16); }

#define XB_TMO      128
#define XB_XCNT(j)  (256  + 64 * (j))
#define XB_XSUB(j)  (1280 + 64 * (j))
#define XB_XGEN(j)  (2304 + 64 * (j))
#define XB_TOP      3328
#define XB_TOPGEN   3392
#define XCD_BAR_WORDS 3456
#define XB_SPIN_CAP (1u << 18)

__device__ __forceinline__ unsigned xb_ld(unsigned* p)              { return __hip_atomic_load(p, __ATOMIC_RELAXED, __HIP_MEMORY_SCOPE_AGENT); }
__device__ __forceinline__ unsigned xb_add(unsigned* p, unsigned v) { return __hip_atomic_fetch_add(p, v, __ATOMIC_RELAXED, __HIP_MEMORY_SCOPE_AGENT); }
__device__ __forceinline__ unsigned xb_xcc_id() { return (unsigned)__builtin_amdgcn_s_getreg((3 << 11) | 20) & 0xFu; }
#define XB_SPIN(cond, bar) do { unsigned _sp = 0; while (cond) { __builtin_amdgcn_s_sleep(1); \
    if ((++_sp & 255u) == 0u) { if (xb_ld(&(bar)[XB_TMO])) break; if (_sp > XB_SPIN_CAP) { atomicAdd(&(bar)[XB_TMO], 1u); break; } } } } while (0)

struct XcdBarrier {
    unsigned* bar; unsigned x;
    volatile LAS unsigned* st;
};

__device__ __forceinline__ XcdBarrier xcd_barrier_post(unsigned* bar, volatile LAS unsigned* st) {
    XcdBarrier b; b.bar = bar; b.x = xb_xcc_id(); b.st = st;
    if (threadIdx.x == 0) (void)xb_add(&bar[XB_XCNT(b.x)], 1u);
    return b;
}
__device__ __forceinline__ void xcd_barrier_complete(unsigned* bar, unsigned x, unsigned& nloc, unsigned& nx) {
    const unsigned G = gridDim.x * gridDim.y * gridDim.z;
    unsigned sum, cnt, mine, sp = 0u;
    for (;;) {
        sum = 0u; cnt = 0u; mine = 0u;
#pragma unroll
        for (unsigned j = 0; j < 16; ++j) { const unsigned c = xb_ld(&bar[XB_XCNT(j)]); sum += c; cnt += (c > 0u) ? 1u : 0u; mine = (j == x) ? c : mine; }
        if (sum == G) break;
        __builtin_amdgcn_s_sleep(1);
        if ((++sp & 255u) == 0u) { if (xb_ld(&bar[XB_TMO])) break; if (sp > XB_SPIN_CAP) { atomicAdd(&bar[XB_TMO], 1u); break; } }
    }
    nloc = mine > 0u ? mine : 1u; nx = cnt > 0u ? cnt : 1u;
}

__device__ __forceinline__ void xcd_barrier(const XcdBarrier& b) {
    asm volatile("s_waitcnt vmcnt(0)" ::: "memory");
    __syncthreads();
    if (threadIdx.x == 0) {
        unsigned* bar = b.bar;
        __builtin_amdgcn_s_waitcnt(0);
        unsigned nloc = b.st[0], nx = b.st[1];
        if (nloc == 0u) { xcd_barrier_complete(bar, b.x, nloc, nx); b.st[0] = nloc; b.st[1] = nx; }
        const unsigned old = xb_add(&bar[XB_XSUB(b.x)], 1u);
        const unsigned gen = old / nloc;
        if (old + 1u == (gen + 1u) * nloc) {
            __builtin_amdgcn_fence(__ATOMIC_RELEASE, "agent");
            asm volatile("s_waitcnt vmcnt(0)" ::: "memory");
            const unsigned og = xb_add(&bar[XB_TOP], 1u);
            const unsigned tg = og / nx;
            if (og + 1u == (tg + 1u) * nx) xb_add(&bar[XB_TOPGEN], 1u);
            else XB_SPIN(xb_ld(&bar[XB_TOPGEN]) == tg, bar);
            __builtin_amdgcn_fence(__ATOMIC_ACQUIRE, "agent");
            xb_add(&bar[XB_XGEN(b.x)], 1u);
            asm volatile("s_waitcnt vmcnt(0)" ::: "memory");
        } else {
            XB_SPIN(xb_ld(&bar[XB_XGEN(b.x)]) == gen, bar);
            __builtin_amdgcn_fence(__ATOMIC_ACQUIRE, "agent");
            asm volatile("s_waitcnt vmcnt(0)" ::: "memory");
        }
    }
    __syncthreads();
}


namespace att {
using bf16x8 = __attribute__((ext_vector_type(8))) short;
using s16x4  = __attribute__((ext_vector_type(4))) short;
using f32x16 = __attribute__((ext_vector_type(16))) float;
using u32x4  = __attribute__((ext_vector_type(4))) unsigned;
constexpr int D = 128, NW = 8, QBLK = 32, KVBLK = 64;
constexpr int LDQ = 3072, LDO = 2048;
constexpr float SCALE = 0.088388347648318440f;
constexpr float THR = 4.f;
constexpr size_t SHM_V = KVBLK * D * 2, SHM_K = KVBLK * D * 2, NBUF = 3, SHM_ATTN = NBUF * SHM_V + NBUF * SHM_K + NW * 64 * 4;
#define KSWZ(row, colB) ((row) * 256 + ((colB) ^ (((row) & 7) << 4)))
#define SBAR() __builtin_amdgcn_sched_barrier(0)
__device__ __forceinline__ int crow(int r, int hi) { return (r & 3) + 8 * (r >> 2) + 4 * hi; }
__device__ __forceinline__ unsigned cvtpk(float lo, float hi) { unsigned r; asm volatile("v_cvt_pk_bf16_f32 %0, %1, %2" : "=v"(r) : "v"(lo), "v"(hi)); return r; }

__device__ __forceinline__ void partialSM(f32x16& p0, f32x16& p1, float& m_reg, float& mn, float& alpha) {
  constexpr float C = SCALE * 1.4426950408889634f;
  float pmax = p0[0];
#pragma unroll
  for (int r = 1; r < 16; ++r) pmax = fmaxf(pmax, p0[r]);
#pragma unroll
  for (int r = 0; r < 16; ++r) pmax = fmaxf(pmax, p1[r]);
  { auto rr = __builtin_amdgcn_permlane32_swap(__float_as_uint(pmax), __float_as_uint(pmax), false, false);
    pmax = fmaxf(__uint_as_float(rr[0]), __uint_as_float(rr[1])); }
  if (__builtin_expect(__all(pmax - m_reg <= THR / SCALE), 1)) { mn = m_reg; alpha = 1.f; }
  else { mn = fmaxf(m_reg, pmax); alpha = __builtin_amdgcn_exp2f((m_reg - mn) * C); m_reg = mn; }
  float mnC = -mn * C;
#pragma unroll
  for (int r = 0; r < 16; ++r) p0[r] = fmaf(p0[r], C, mnC);
#pragma unroll
  for (int r = 0; r < 16; ++r) p1[r] = fmaf(p1[r], C, mnC);
#pragma unroll
  for (int r = 0; r < 16; ++r) p0[r] = __builtin_amdgcn_exp2f(p0[r]);
}
__device__ __forceinline__ void finishSM(f32x16& p0, f32x16& p1, float alpha, float& l_reg, bf16x8& pa0, bf16x8& pa1, bf16x8& pa2, bf16x8& pa3) {
#pragma unroll
  for (int r = 0; r < 16; ++r) p1[r] = __builtin_amdgcn_exp2f(p1[r]);
  float ps = 0;
#pragma unroll
  for (int r = 0; r < 16; ++r) ps += p0[r];
#pragma unroll
  for (int r = 0; r < 16; ++r) ps += p1[r];
  { auto rr = __builtin_amdgcn_permlane32_swap(__float_as_uint(ps), __float_as_uint(ps), false, false);
    ps = __uint_as_float(rr[0]) + __uint_as_float(rr[1]); }
  l_reg = l_reg * alpha + ps;
#define PK4(P, BASE, OUT) do { unsigned a0 = cvtpk(P[BASE + 0], P[BASE + 1]), a1 = cvtpk(P[BASE + 2], P[BASE + 3]);   \
    unsigned b0 = cvtpk(P[BASE + 4], P[BASE + 5]), b1 = cvtpk(P[BASE + 6], P[BASE + 7]);                              \
    auto r0 = __builtin_amdgcn_permlane32_swap(a0, b0, false, false); auto r1 = __builtin_amdgcn_permlane32_swap(a1, b1, false, false); \
    u32x4 w = {r0[0], r1[0], r0[1], r1[1]}; OUT = *reinterpret_cast<bf16x8*>(&w); } while (0)
  PK4(p0, 0, pa0); PK4(p0, 8, pa1); PK4(p1, 0, pa2); PK4(p1, 8, pa3);
#undef PK4
}
__device__ __forceinline__ void qkt(f32x16& p0, f32x16& p1, const char* Ks, const bf16x8* qr, int r32, int hi) {
  p0 = f32x16{}; p1 = f32x16{};
#pragma unroll
  for (int d0 = 0; d0 < 8; ++d0) { int cb = (d0 * 16 + hi * 8) * 2;
    bf16x8 b0 = *reinterpret_cast<const bf16x8*>(Ks + KSWZ(r32, cb));
    bf16x8 b1 = *reinterpret_cast<const bf16x8*>(Ks + KSWZ(32 + r32, cb));
    p0 = __builtin_amdgcn_mfma_f32_32x32x16_bf16(b0, qr[d0], p0, 0, 0, 0);
    p1 = __builtin_amdgcn_mfma_f32_32x32x16_bf16(b1, qr[d0], p1, 0, 0, 0); }
}
__device__ __forceinline__ void mask_tile(f32x16& p0, f32x16& p1, int dlt0, int hi) {
#pragma unroll
  for (int r = 0; r < 16; ++r) { const int d = dlt0 + crow(r, hi);
    if (d < -128 || d > 128) p0[r] = -1e30f;
    if (d + 32 < -128 || d + 32 > 128) p1[r] = -1e30f; }
}
__device__ __forceinline__ int v_st(int k, int c) { const int kk = (k & ~0xC) | ((k & 4) << 1) | ((k & 8) >> 1); return ((kk >> 3) * 4 + (c >> 5)) * 512 + ((kk & 7) * 32 + (c & 31)) * 2; }
__device__ __forceinline__ int v_rd_base(int lane) { return ((lane & 3) << 3) | (((lane >> 2) & 3) << 6) | (((lane >> 4) & 1) << 5) | (((lane >> 5) & 1) << 8); }
constexpr int v_rd_off(int d0, int ks, int half) { return d0 * 512 + ks * 4096 + half * 2048; }
template <int OFF> __device__ __forceinline__ s16x4 tr_read(int vb) {
  s16x4 r; asm volatile("ds_read_b64_tr_b16 %0, %1 offset:%2" : "=&v"(r) : "v"(vb), "i"(OFF) : "memory"); return r;
}
template <int D0> __device__ __forceinline__ void pv_one(f32x16& od, int vb, bf16x8 pa0, bf16x8 pa1, bf16x8 pa2, bf16x8 pa3) {
  const s16x4 l0 = tr_read<v_rd_off(D0, 0, 0)>(vb), h0 = tr_read<v_rd_off(D0, 0, 1)>(vb), l1 = tr_read<v_rd_off(D0, 1, 0)>(vb), h1 = tr_read<v_rd_off(D0, 1, 1)>(vb);
  const s16x4 l2 = tr_read<v_rd_off(D0, 2, 0)>(vb), h2 = tr_read<v_rd_off(D0, 2, 1)>(vb), l3 = tr_read<v_rd_off(D0, 3, 0)>(vb), h3 = tr_read<v_rd_off(D0, 3, 1)>(vb);
  asm volatile("s_waitcnt lgkmcnt(0)" ::: "memory"); SBAR();
#define PK(L, H) (bf16x8){L[0], L[1], L[2], L[3], H[0], H[1], H[2], H[3]}
  od = __builtin_amdgcn_mfma_f32_32x32x16_bf16(pa0, PK(l0, h0), od, 0, 0, 0);
  od = __builtin_amdgcn_mfma_f32_32x32x16_bf16(pa1, PK(l1, h1), od, 0, 0, 0);
  od = __builtin_amdgcn_mfma_f32_32x32x16_bf16(pa2, PK(l2, h2), od, 0, 0, 0);
  od = __builtin_amdgcn_mfma_f32_32x32x16_bf16(pa3, PK(l3, h3), od, 0, 0, 0);
#undef PK
}
__device__ __forceinline__ void pv_d0(f32x16* o, int vb, bf16x8 pa0, bf16x8 pa1, bf16x8 pa2, bf16x8 pa3) {
  pv_one<0>(o[0], vb, pa0, pa1, pa2, pa3); pv_one<1>(o[1], vb, pa0, pa1, pa2, pa3); pv_one<2>(o[2], vb, pa0, pa1, pa2, pa3); pv_one<3>(o[3], vb, pa0, pa1, pa2, pa3);
}

struct UnitP { int qrow0, hd0, grp, kcol, vcol, win_row0, kpos_start, nwin, ctx_row0, qpos0, pad; };
__device__ __forceinline__ UnitP unit_params(int u) {
  constexpr int SEQ_ = 2048, ML_ = 16384, CTXL_ = 256;
  UnitP P;
  if (u < 1024) { const int qb = u & 31, hk = (u >> 5) & 3, b = u >> 7;
    const int P0 = qb * 64; const int k0 = (P0 - 128 < 0) ? 0 : P0 - 128, k1 = (P0 + 192 > SEQ_) ? SEQ_ : P0 + 192; const int n = (k1 - k0) >> 6;
    P.pad = n & 1;
    P.qrow0 = b * SEQ_ + P0; P.hd0 = hk * 4; P.grp = 1; P.kcol = 2048 + hk * 128; P.vcol = 2560 + hk * 128; P.win_row0 = b * SEQ_ + k0; P.kpos_start = k0; P.nwin = n;
    P.ctx_row0 = ML_ + b * CTXL_; P.qpos0 = P0; }
  else { const int uc = u - 1024, h = uc & 15, b = uc >> 4, hk = h >> 2;
    P.qrow0 = ML_ + b * CTXL_; P.hd0 = h; P.grp = 0; P.kcol = 2048 + hk * 128; P.vcol = 2560 + hk * 128; P.win_row0 = 0; P.kpos_start = 0; P.nwin = 0; P.ctx_row0 = ML_ + b * CTXL_; P.qpos0 = 0; P.pad = 0; }
  return P;
}
__device__ __forceinline__ int unit_at(int i, int c, int G) {
  if (G == 256) {
    if (i < 4) return c + 256 * i;
    const int qb = c & 31; const bool edge = qb < 2 || qb >= 30;
    if (edge) { const int r = ((c >> 5) << 2) + (qb < 2 ? qb : qb - 28); return i < 6 ? 1024 + 2 * r + (i - 4) : -1; }
    const int s = (c >> 5) * 28 + (qb - 2);
    return (i == 4 && s < 64) ? 1024 + 64 + s : -1;
  }
  const int u = c + G * i; return u < 1024 + 128 ? u : -1;
}
__device__ __forceinline__ void attn_units(const unsigned short* __restrict__ QKV, unsigned short* __restrict__ Og, const float* sinkp, int u0, int ustep, char* lds) {
  int tid_o = threadIdx.x; asm volatile("" : "+v"(tid_o));
  asm volatile("" : "+s"(u0));
  const int tid = tid_o, wid = __builtin_amdgcn_readfirstlane(tid >> 6), lane = tid & 63, r32 = lane & 31, hi = lane >> 5;
#define WROW(PP) ((PP).grp ? 32 * (wid & 1) : 32 * wid)
#define WHEAD(PP) ((PP).hd0 + ((PP).grp ? (wid >> 1) : 0))
  char* V_lds = lds; char* K_lds = lds + NBUF * SHM_V;
  float* ws = (float*)(lds + NBUF * SHM_V + NBUF * SHM_K) + wid * 64; float* li_l = ws; float* al_l = ws + 32;
  const int sr = tid >> 4, sc = (tid & 15) * 8, vst0 = v_st(sr, sc), vst1 = v_st(32 + sr, sc);
  const int vb0 = (int)(uintptr_t)V_lds + v_rd_base(lane);
  bf16x8 qr[8];
  struct { bf16x8 vs0, vs1, ks0, ks1; } sr_[2];
  constexpr int SE = 0, SO = 1;
#define TROWP(PP, j) ((j) < (PP).nwin ? (PP).win_row0 + 64 * (j) : (PP).ctx_row0 + 64 * (((j) - (PP).nwin) & 3))
#define SLOADP(PP, i, j) do { const unsigned short* tb_ = QKV + (size_t)(TROWP(PP, j) + sr) * LDQ + sc; \
    sr_[i].vs0 = *reinterpret_cast<const bf16x8*>(tb_ + (PP).vcol); sr_[i].vs1 = *reinterpret_cast<const bf16x8*>(tb_ + (size_t)32 * LDQ + (PP).vcol); \
    sr_[i].ks0 = *reinterpret_cast<const bf16x8*>(tb_ + (PP).kcol); sr_[i].ks1 = *reinterpret_cast<const bf16x8*>(tb_ + (size_t)32 * LDQ + (PP).kcol); } while (0)
#define QLOADP(PP) do { const unsigned short* Qw_ = QKV + (size_t)((PP).qrow0 + WROW(PP) + r32) * LDQ + WHEAD(PP) * 128 + hi * 8; \
    _Pragma("unroll") for (int d0 = 0; d0 < 8; ++d0) qr[d0] = *reinterpret_cast<const bf16x8*>(Qw_ + d0 * 16); } while (0)
#define SLOAD(i, j) SLOADP(P, i, j)
#define SWRITE(b, i) do { *(bf16x8*)(V_lds + (b) * SHM_V + vst0) = sr_[i].vs0; *(bf16x8*)(V_lds + (b) * SHM_V + vst1) = sr_[i].vs1; int kc = sc * 2; \
    *(bf16x8*)(K_lds + (b) * SHM_K + KSWZ(sr, kc)) = sr_[i].ks0; *(bf16x8*)(K_lds + (b) * SHM_K + KSWZ(32 + sr, kc)) = sr_[i].ks1; } while (0)
#define SWAIT() asm volatile("s_waitcnt vmcnt(4)" ::: "memory")
#define RESC(a) do { if (__any((a) < 1.f)) { if (hi == 0) al_l[r32] = (a); asm volatile("s_waitcnt lgkmcnt(0)" ::: "memory"); \
    _Pragma("unroll") for (int d = 0; d < 4; ++d) _Pragma("unroll") for (int r = 0; r < 16; ++r) o[d][r] *= al_l[crow(r, hi)]; } } while (0)
#define MASK(P0_, P1_, j) do { if ((j) < nwin) { const int kp0_ = P.kpos_start + 64 * (j); \
    if (!(kp0_ - (qpmin + 31) >= -128 && kp0_ + 63 - qpmin <= 128)) mask_tile(P0_, P1_, kp0_ - qpos, hi); } } while (0)
  int ucur = unit_at(0, u0, ustep);
  if (ucur < 0) return;
  UnitP P = unit_params(ucur);
  QLOADP(P); SLOADP(P, SE, 0);
  for (int ui = 0; ucur >= 0; ++ui) {
    const int unext = unit_at(ui + 1, u0, ustep);
    const bool has_next = unext >= 0;
    const UnitP PN = unit_params(has_next ? unext : ucur);
    const int nwin = P.nwin, NT = nwin + 4 + P.pad;
    const int qpos = P.qpos0 + WROW(P) + r32, qpmin = P.qpos0 + WROW(P);
    float m_reg = sinkp[WHEAD(P)] * (1.0f / SCALE), l_reg = 1.f; f32x16 o[4] = {};
    f32x16 pA0, pA1, pB0, pB1; float mnA, mnB, alA, alB; bf16x8 pa0, pa1, pa2, pa3;
#define KB(b) (K_lds + (b) * SHM_K)
#define VB(b) (vb0 + (int)((b) * SHM_V))
#define INC3(b) ((b) == 2 ? 0 : (b) + 1)
    SWRITE(0, SE); __syncthreads();
    qkt(pA0, pA1, KB(0), qr, r32, hi); MASK(pA0, pA1, 0); partialSM(pA0, pA1, m_reg, mnA, alA);
    SLOAD(SO, 1); if (2 < NT) SLOAD(SE, 2);
    SWAIT(); SWRITE(1, SO); __syncthreads();
    int bj = 1;
    for (int j = 1; j + 1 < NT; j += 2) {
      const int bp = INC3(bj), bm = INC3(bp);
      SBAR(); qkt(pB0, pB1, KB(bj), qr, r32, hi);
      finishSM(pA0, pA1, alA, l_reg, pa0, pa1, pa2, pa3); SBAR();
      SLOAD(SO, j + 2); SBAR();
      pv_d0(o, VB(bm), pa0, pa1, pa2, pa3); MASK(pB0, pB1, j); partialSM(pB0, pB1, m_reg, mnB, alB);
      SWAIT(); SWRITE(bp, SE);
      RESC(alB); __syncthreads();
      SBAR(); qkt(pA0, pA1, KB(bp), qr, r32, hi);
      finishSM(pB0, pB1, alB, l_reg, pa0, pa1, pa2, pa3); SBAR();
      if (j + 3 < NT) SLOAD(SE, j + 3); SBAR();
      pv_d0(o, VB(bj), pa0, pa1, pa2, pa3); MASK(pA0, pA1, j + 1); partialSM(pA0, pA1, m_reg, mnA, alA);
      SWAIT(); SWRITE(bm, SO);
      RESC(alA); __syncthreads();
      bj = bm;
    }
    const bool real = P.pad == 0;
    { const int bm = INC3(INC3(bj));
    SBAR(); qkt(pB0, pB1, KB(bj), qr, r32, hi);
    finishSM(pA0, pA1, alA, l_reg, pa0, pa1, pa2, pa3); SBAR();
    pv_d0(o, VB(bm), pa0, pa1, pa2, pa3);
    if (real) { MASK(pB0, pB1, NT - 1); partialSM(pB0, pB1, m_reg, mnB, alB);
      RESC(alB);
      finishSM(pB0, pB1, alB, l_reg, pa0, pa1, pa2, pa3); SBAR();
      pv_d0(o, VB(bj), pa0, pa1, pa2, pa3); } }
    if (has_next) { QLOADP(PN); SLOADP(PN, SE, 0); }
    if (hi == 0) li_l[r32] = l_reg; asm volatile("s_waitcnt lgkmcnt(0)" ::: "memory");
    float rli[16];
#pragma unroll
    for (int r = 0; r < 16; ++r) rli[r] = __builtin_amdgcn_rcpf(li_l[crow(r, hi)]);
    unsigned short* Ow = Og + (size_t)(P.qrow0 + WROW(P)) * LDO + WHEAD(P) * 128;
#pragma unroll
    for (int r = 0; r < 16; ++r) { const int orow = crow(r, hi);
#pragma unroll
      for (int d0 = 0; d0 < 4; ++d0) { const unsigned w = cvtpk(o[d0][r] * rli[r], 0.f); Ow[(size_t)orow * LDO + d0 * 32 + r32] = (unsigned short)(w & 0xffffu); } }
    __syncthreads();
    P = PN; ucur = unext;
  }
#undef KB
#undef VB
#undef INC3
#undef WROW
#undef WHEAD
#undef TROWP
#undef SLOADP
#undef QLOADP
#undef SLOAD
#undef SWRITE
#undef SWAIT
#undef RESC
#undef MASK
}
#undef KSWZ
#undef SBAR
}


namespace scn {
using bf16x8 = __attribute__((ext_vector_type(8))) short;
using f32x4  = __attribute__((ext_vector_type(4))) float;
using f32x2  = __attribute__((ext_vector_type(2))) float;
using u32x4  = __attribute__((ext_vector_type(4))) unsigned;
using u32x2  = __attribute__((ext_vector_type(2))) unsigned;
using f16x2  = __attribute__((ext_vector_type(2))) _Float16;
constexpr int CH = 32, NCHUNK = 72, NCTXCH = 8;
constexpr float DCLAMP = -115.41560327111707f;
constexpr int QK_STRIDE = 272, T_STRIDE = 80;
constexpr int QS = 0, KS = QS + CH * QK_STRIDE, KT = KS + CH * QK_STRIDE, VT = KT + 128 * T_STRIDE, BUF_BYTES = VT + 128 * T_STRIDE;
constexpr int PS0 = 3 * BUF_BYTES, PS_BYTES = CH * T_STRIDE, TT0 = PS0 + 2 * PS_BYTES, TT_BYTES = 8 * 128 * 4, SC0 = TT0 + 2 * TT_BYTES, SC_BYTES = 512, SCAN_LDS = SC0 + 4 * SC_BYTES;
constexpr int OS0 = 135168, OS1 = 147456, OS_STRIDE = 272, OS_BYTES = CH * OS_STRIDE, SCAN_LDS_TOP = OS1 + OS_BYTES;
static_assert(SCAN_LDS <= 131072 && (BUF_BYTES % 16) == 0 && (KT % 16) == 0 && (VT % 16) == 0 && (PS0 % 16) == 0 && (PS_BYTES % 16) == 0 && (TT0 % 16) == 0 && (SC0 % 16) == 0, "scan LDS");
__device__ __forceinline__ unsigned cvtpk(float lo, float hi) { unsigned r; asm volatile("v_cvt_pk_bf16_f32 %0, %1, %2" : "=v"(r) : "v"(lo), "v"(hi)); return r; }
__device__ __forceinline__ float bflo(unsigned w) { return __uint_as_float(w << 16); }
__device__ __forceinline__ float bfhi(unsigned w) { return __uint_as_float(w & 0xffff0000u); }

__device__ __forceinline__ int tok_row(int b, int dir, int ci, int tt) {
    if (ci < NCTXCH) { const int n = ci * CH + tt; return 16384 + b * 256 + (dir ? 255 - n : n); }
    const int n = (ci - NCTXCH) * CH + tt; return b * 2048 + (dir ? 2047 - n : n);
}
struct ScanCtx { const unsigned short* RQ; const unsigned short* RV; const _Float16* LFd; unsigned short* OUT; int b, h, dir, w; unsigned col2; unsigned so[4]; };
struct ChunkIn { unsigned lfr[4]; unsigned qv[4], vv[4]; float cA[4], cB[4]; };

__device__ __forceinline__ void scan_load(ChunkIn& I, const ScanCtx& C, int ci) {
#pragma unroll
    for (int i = 0; i < 4; ++i) { const size_t rb = (size_t)tok_row(C.b, C.dir, ci, 4 * C.w + i) * 2048 + C.h * 128;
        I.lfr[i] = *(const unsigned*)(C.LFd + rb + C.col2); I.qv[i] = *(const unsigned*)(C.RQ + rb + C.col2); I.vv[i] = *(const unsigned*)(C.RV + rb + C.col2); }
}
__device__ __forceinline__ void scan_cum(ChunkIn& I, char* lds, int ci, int w, int k2) {
    float sA = 0.f, sB = 0.f;
#pragma unroll
    for (int i = 0; i < 4; ++i) { const f16x2 l2 = __builtin_bit_cast(f16x2, I.lfr[i]); sA += (float)l2.x; sB += (float)l2.y; I.cA[i] = sA; I.cB[i] = sB; }
    *(f32x2*)(lds + TT0 + (ci & 1) * TT_BYTES + (w * 128 + 2 * k2) * 4) = (f32x2){sA, sB};
}
__device__ __forceinline__ void scan_prep(const ChunkIn& I, char* lds, int bo, int ci, int w, int k2) {
    float offA = 0.f, offB = 0.f, totA = 0.f, totB = 0.f;
#pragma unroll
    for (int s = 0; s < 8; ++s) { const f32x2 t = *(const f32x2*)(lds + TT0 + (ci & 1) * TT_BYTES + (s * 128 + 2 * k2) * 4);
        const float ms = (s < w) ? 1.0f : 0.0f;
        offA = fmaf(t.x, ms, offA); offB = fmaf(t.y, ms, offB); totA += t.x; totB += t.y; }
    unsigned qt[4], kt[4]; float kA_[4], kB_[4];
#pragma unroll
    for (int i = 0; i < 4; ++i) {
        const float dA = fmaxf(offA + I.cA[i], DCLAMP), dB = fmaxf(offB + I.cB[i], DCLAMP);
        const float eA = __builtin_amdgcn_exp2f(dA), eB = __builtin_amdgcn_exp2f(dB), ieA = __builtin_amdgcn_exp2f(-dA), ieB = __builtin_amdgcn_exp2f(-dB);
        const f16x2 l2 = __builtin_bit_cast(f16x2, I.lfr[i]);
        const float kkA = 1.0f - __builtin_amdgcn_exp2f((float)l2.x), kkB = 1.0f - __builtin_amdgcn_exp2f((float)l2.y);
        const float qA = bflo(I.qv[i]) * eA, qB = bfhi(I.qv[i]) * eB; kA_[i] = kkA * ieA; kB_[i] = kkB * ieB;
        qt[i] = cvtpk(qA, qB); kt[i] = cvtpk(kA_[i], kB_[i]);
    }
    char* B = lds + bo;
#pragma unroll
    for (int i = 0; i < 4; ++i) { *(unsigned*)(B + QS + (4 * w + i) * QK_STRIDE + 4 * k2) = qt[i]; *(unsigned*)(B + KS + (4 * w + i) * QK_STRIDE + 4 * k2) = kt[i]; }
    *(u32x2*)(B + KT + (2 * k2) * T_STRIDE + 8 * w) = (u32x2){cvtpk(kA_[0], kA_[1]), cvtpk(kA_[2], kA_[3])};
    *(u32x2*)(B + KT + (2 * k2 + 1) * T_STRIDE + 8 * w) = (u32x2){cvtpk(kB_[0], kB_[1]), cvtpk(kB_[2], kB_[3])};
    *(u32x2*)(B + VT + (2 * k2) * T_STRIDE + 8 * w) = (u32x2){(I.vv[0] & 0xffffu) | (I.vv[1] << 16), (I.vv[2] & 0xffffu) | (I.vv[3] << 16)};
    *(u32x2*)(B + VT + (2 * k2 + 1) * T_STRIDE + 8 * w) = (u32x2){(I.vv[0] >> 16) | (I.vv[1] & 0xffff0000u), (I.vv[2] >> 16) | (I.vv[3] & 0xffff0000u)};
    if (w == 0) *(f32x2*)(lds + SC0 + (ci & 3) * SC_BYTES + 8 * k2) = (f32x2){__builtin_amdgcn_exp2f(fmaxf(totA, DCLAMP)), __builtin_amdgcn_exp2f(fmaxf(totB, DCLAMP))};
}
__device__ __forceinline__ void scan_ptile(char* lds, int bo, int pso, int w, int l15, int q4) {
    if (w < 4) { const char* B = lds + bo; const int sb = w >> 1, tb = w & 1; f32x4 p = (f32x4){0.f, 0.f, 0.f, 0.f};
        if (sb <= tb) {
#pragma unroll
            for (int ks = 0; ks < 4; ++ks) { const bf16x8 a = *(const bf16x8*)(B + KS + (16 * sb + l15) * QK_STRIDE + 64 * ks + 16 * q4);
                const bf16x8 bq = *(const bf16x8*)(B + QS + (16 * tb + l15) * QK_STRIDE + 64 * ks + 16 * q4);
                p = __builtin_amdgcn_mfma_f32_16x16x32_bf16(a, bq, p, 0, 0, 0); }
            const int t = 16 * tb + l15, s0 = 16 * sb + 4 * q4;
#pragma unroll
            for (int r = 0; r < 4; ++r) p[r] = (s0 + r <= t) ? p[r] : 0.f;
        }
        *(u32x2*)(lds + pso + (16 * tb + l15) * T_STRIDE + (16 * sb + 4 * q4) * 2) = (u32x2){cvtpk(p[0], p[1]), cvtpk(p[2], p[3])}; }
}
template <int MODE = 15> __device__ __forceinline__ void scan_main(f32x4 (&acc)[8], char* lds, int bo, int pso, int sco, const ScanCtx& C, int ci, int w, int l15, int q4) {
    const char* B = lds + bo;
#pragma unroll
    for (int kt = 0; kt < 8; ++kt) acc[kt] = acc[kt] * *(const f32x4*)(lds + sco + (16 * kt + 4 * q4) * 4);
    f32x4 o[2];
#pragma unroll
    for (int tt = 0; tt < 2; ++tt) o[tt] = (f32x4){0.f, 0.f, 0.f, 0.f};
#pragma unroll
    for (int j = 0; j < 4; ++j) {
        const u32x4 bw = (u32x4){cvtpk(acc[2 * j][0], acc[2 * j][1]), cvtpk(acc[2 * j][2], acc[2 * j][3]), cvtpk(acc[2 * j + 1][0], acc[2 * j + 1][1]), cvtpk(acc[2 * j + 1][2], acc[2 * j + 1][3])};
        const bf16x8 bs = __builtin_bit_cast(bf16x8, bw);
#pragma unroll
        for (int tt = 0; tt < 2; ++tt) { const char* row = B + QS + (16 * tt + l15) * QK_STRIDE + (32 * j + 4 * q4) * 2;
            const u32x2 a0 = *(const u32x2*)row, a1 = *(const u32x2*)(row + 32);
            const u32x4 aw = (u32x4){a0.x, a0.y, a1.x, a1.y};
            o[tt] = __builtin_amdgcn_mfma_f32_16x16x32_bf16(__builtin_bit_cast(bf16x8, aw), bs, o[tt], 0, 0, 0); }
    }
    const bf16x8 bv = *(const bf16x8*)(B + VT + (16 * w + l15) * T_STRIDE + 16 * q4);
#pragma unroll
    for (int tt = 0; tt < 2; ++tt) { const bf16x8 ap = *(const bf16x8*)(lds + pso + (16 * tt + l15) * T_STRIDE + 16 * q4);
        o[tt] = __builtin_amdgcn_mfma_f32_16x16x32_bf16(ap, bv, o[tt], 0, 0, 0); }
#pragma unroll
    for (int kt = 0; kt < 8; ++kt) { const bf16x8 ak = *(const bf16x8*)(B + KT + (16 * kt + l15) * T_STRIDE + 16 * q4);
        acc[kt] = __builtin_amdgcn_mfma_f32_16x16x32_bf16(ak, bv, acc[kt], 0, 0, 0); }
    char* os = lds + ((ci & 1) ? OS1 : OS0);
#pragma unroll
    for (int tt = 0; tt < 2; ++tt)
#pragma unroll
        for (int r = 0; r < 4; ++r) *(unsigned short*)(os + (16 * tt + 4 * q4 + r) * OS_STRIDE + (16 * w + l15) * 2) = (unsigned short)(cvtpk(o[tt][r], 0.f) & 0xffffu);
}
__device__ __forceinline__ void scan_flush(char* lds, const ScanCtx& C, int ci, int tid) {
    const int t = tid >> 4, pc = tid & 15;
    const u32x4 v = *(const u32x4*)(lds + ((ci & 1) ? OS1 : OS0) + t * OS_STRIDE + pc * 16);
    const int row0 = tok_row(C.b, C.dir, ci, 0), row = C.dir ? row0 - t : row0 + t;
    *(u32x4*)(C.OUT + (size_t)row * 2048 + C.h * 128 + pc * 8) = v;
}
template <int MODE = 15> __device__ __forceinline__ void scan_seq(const unsigned short* __restrict__ RQ, const unsigned short* __restrict__ RV, const _Float16* __restrict__ LFd, unsigned short* __restrict__ OUT,
                                         int b, int h, int dir, char* lds) {
    int tid_o = threadIdx.x; asm volatile("" : "+v"(tid_o));
    const int tid = tid_o, w = __builtin_amdgcn_readfirstlane(tid >> 6), lane = tid & 63, l15 = lane & 15, q4 = lane >> 4;
    const int k2 = lane;
    ScanCtx C{RQ, RV, LFd, OUT, b, h, dir, w, (unsigned)(2 * k2), {0u, 0u, 0u, 0u}};
#pragma unroll
    for (int r = 0; r < 4; ++r) C.so[r] = (unsigned)((dir ? 15 - (4 * q4 + r) : 4 * q4 + r) * 2048 + l15);
    f32x4 acc[8];
#pragma unroll
    for (int i = 0; i < 8; ++i) acc[i] = (f32x4){0.f, 0.f, 0.f, 0.f};
    if (tid < 128) ((float*)(lds + SC0 + 3 * SC_BYTES))[tid] = 1.0f;
    ChunkIn IA, IB, IC;
    scan_load(IA, C, 0); scan_load(IB, C, 1); scan_load(IC, C, 2);
    scan_cum(IA, lds, 0, w, k2); scan_cum(IB, lds, 1, w, k2); __syncthreads();
    scan_prep(IA, lds, 0, 0, w, k2); scan_prep(IB, lds, BUF_BYTES, 1, w, k2); scan_load(IA, C, 3); scan_load(IB, C, 4); __syncthreads();
    scan_cum(IC, lds, 2, w, k2); scan_ptile(lds, 0, PS0, w, l15, q4); __syncthreads();
#define SCN_PSO(c) (PS0 + ((c) & 1) * PS_BYTES)
#define SCN_SCO(c) (SC0 + (((c) + 3) & 3) * SC_BYTES)
    for (int cp = 0; cp < NCHUNK; cp += 3) {
        if (cp > 0) scan_flush(lds, C, cp - 1, tid);
        if (cp + 3 < NCHUNK) if constexpr (MODE & 4) scan_cum(IA, lds, cp + 3, w, k2);
        if constexpr (MODE & 4) scan_prep(IC, lds, 2 * BUF_BYTES, cp + 2, w, k2); if (cp + 5 < NCHUNK) scan_load(IC, C, cp + 5);
        if constexpr (MODE & 8) scan_ptile(lds, BUF_BYTES, SCN_PSO(cp + 1), w, l15, q4);
        if constexpr (MODE & 2) scan_main<MODE>(acc, lds, 0, SCN_PSO(cp), SCN_SCO(cp), C, cp, w, l15, q4); __syncthreads();
        scan_flush(lds, C, cp, tid);
        if (cp + 4 < NCHUNK) if constexpr (MODE & 4) scan_cum(IB, lds, cp + 4, w, k2);
        if (cp + 3 < NCHUNK) { if constexpr (MODE & 4) scan_prep(IA, lds, 0, cp + 3, w, k2); if (cp + 6 < NCHUNK) scan_load(IA, C, cp + 6); }
        if constexpr (MODE & 8) scan_ptile(lds, 2 * BUF_BYTES, SCN_PSO(cp + 2), w, l15, q4);
        if constexpr (MODE & 2) scan_main<MODE>(acc, lds, BUF_BYTES, SCN_PSO(cp + 1), SCN_SCO(cp + 1), C, cp + 1, w, l15, q4); __syncthreads();
        scan_flush(lds, C, cp + 1, tid);
        if (cp + 5 < NCHUNK) if constexpr (MODE & 4) scan_cum(IC, lds, cp + 5, w, k2);
        if (cp + 4 < NCHUNK) { if constexpr (MODE & 4) scan_prep(IB, lds, BUF_BYTES, cp + 4, w, k2); if (cp + 7 < NCHUNK) scan_load(IB, C, cp + 7); }
        if (cp + 3 < NCHUNK) if constexpr (MODE & 8) scan_ptile(lds, 0, SCN_PSO(cp + 3), w, l15, q4);
        if constexpr (MODE & 2) scan_main<MODE>(acc, lds, 2 * BUF_BYTES, SCN_PSO(cp + 2), SCN_SCO(cp + 2), C, cp + 2, w, l15, q4); __syncthreads();
    }
    scan_flush(lds, C, NCHUNK - 1, tid);
#undef SCN_PSO
#undef SCN_SCO
}
}


constexpr int NWAVES = 8;
constexpr int DM = 2048, NBATCH = 8, SEQ = 2048, CTXL = 256, DEPTH = 4;
constexpr int ML = NBATCH * SEQ, MC = NBATCH * CTXL, MT = ML + MC;
constexpr int NQKV = 3072, NREC = 10240, DFF = 8192, NMOD = 12288;
constexpr float NORM_EPS = 1e-6f;
constexpr int N_PHASES = 3 + 8 * DEPTH;

constexpr size_t MiB = 1u << 20;
constexpr size_t WS_CTL = 0, CTL_ZERO_BYTES = 1 * MiB;
constexpr size_t WS_MOD = 1 * MiB;
constexpr size_t WS_TAB = 4 * MiB;
constexpr size_t TAB_COS = 0, TAB_SIN = 8192, TAB_LB = 16384;
constexpr size_t WS_WQKV = 8 * MiB, WS_WAO = 32 * MiB, WS_WRI = 48 * MiB, WS_WRO = 128 * MiB, WS_WUP = 144 * MiB, WS_WDN = 272 * MiB;
constexpr size_t WS_X = 400 * MiB;
constexpr size_t WS_H = 544 * MiB;
constexpr size_t WS_O = 616 * MiB;
constexpr size_t WS_U = 688 * MiB;
constexpr size_t WS_OF = WS_U, WS_OB = WS_U + 72 * MiB;
constexpr size_t WS_GSLAB = WS_U + 144 * MiB;
constexpr size_t WS_MIX = 976 * MiB;
constexpr size_t WS_RQ = WS_MIX, WS_RV = WS_MIX + 72 * MiB, WS_RG = WS_MIX + 144 * MiB, WS_LF = WS_MIX + 216 * MiB;
constexpr size_t WS_END = WS_MIX + 504 * MiB;
constexpr int CW_TMO = 0, CW_BAR = 4096;

constexpr int RING_BYTES = 131072, LDSCTL_OFF = RING_BYTES, MISC_OFF = LDSCTL_OFF + 320, LDS_BYTES = 156672;

__device__ __forceinline__ float xor_get(float v, int lane, int o) { return __int_as_float(__builtin_amdgcn_ds_bpermute((lane ^ o) << 2, __float_as_int(v))); }
__device__ __forceinline__ float wave_sum(float v, int lane) {
#pragma unroll
    for (int o = 1; o < 64; o <<= 1) v += xor_get(v, lane, o);
    return v;
}

__device__ __forceinline__ int rope_row(int n) {
    if (n >= 2560) return n;
    const int d = n & 127, a = d >> 6, jj = (d >> 5) & 1, i = d & 31;
    return (n & ~127) + a * 64 + (i >> 2) * 8 + jj * 4 + (i & 3);
}
__device__ __forceinline__ void transpose_item(const float* W, int K, int N, bf16* WT, bool perm, LAS float* scr, int item, int lane) {
    const int nblk = N / 32, kb = item / nblk, nb = item % nblk, k0 = 64 * kb, n0 = 32 * nb;
    const float* src = W + (size_t)(k0 + (lane >> 5)) * N + n0 + (lane & 31);
    float v[32];
#pragma unroll
    for (int i = 0; i < 32; ++i) v[i] = src[(size_t)(2 * i) * N];
#pragma unroll
    for (int i = 0; i < 32; ++i) scr[(2 * i + (lane >> 5)) * 33 + (lane & 31)] = v[i];
    LDS_WAIT(); asm volatile("" ::: "memory");
    const int c = lane & 7;
#pragma unroll
    for (int j = 0; j < 4; ++j) { const int n = (lane >> 3) + 8 * j; const LAS float* s = scr + (8 * c) * 33 + n;
        v4u o; o.x = pk2(s[0 * 33], s[1 * 33]); o.y = pk2(s[2 * 33], s[3 * 33]); o.z = pk2(s[4 * 33], s[5 * 33]); o.w = pk2(s[6 * 33], s[7 * 33]);
        const int row = perm ? rope_row(n0 + n) : (n0 + n);
        *(GAS v4u*)(WT + (size_t)row * K + k0 + 8 * c) = o; }
    LDS_WAIT(); asm volatile("" ::: "memory");
}

struct KArgs { const float* in[18]; float* out; unsigned char* ws; int ph_lo, ph_hi; };

__device__ __forceinline__ unsigned long long ld_u64(volatile LAS unsigned* PT, int idx);
__device__ __forceinline__ void p0_prologue(volatile LAS unsigned* PT, LAS unsigned char* lds, int tid, int lane, int wave, int gw, int NGW) {
    unsigned char* ws = (unsigned char*)(GAS unsigned char*)ld_u64(PT, 19);
    LAS float* sc = (LAS float*)lds;
    for (int i = tid; i < 9 * DM; i += NWAVES * 64) { const float x = i < 8 * DM ? ((const float*)(const GAS float*)ld_u64(PT, 1))[i] : ((const float*)(const GAS float*)ld_u64(PT, 3))[i - 8 * DM]; sc[i] = x / (1.0f + __expf(-x)); }
    __syncthreads();
    { float* PART = (float*)(ws + WS_U);
      for (int tk = gw; tk < DEPTH * 48 * 16; tk += NGW) {
          const int i = tk / 768, rem = tk % 768, cg = rem >> 4, ks = rem & 15, col = cg * 256 + 4 * lane;
          const float* W = ((const float*)(const GAS float*)ld_u64(PT, 4)) + (size_t)i * DM * NMOD + (size_t)(ks * 128) * NMOD + col;
          f32x4 acc[9];
#pragma unroll
          for (int r = 0; r < 9; ++r) acc[r] = (f32x4){0.f, 0.f, 0.f, 0.f};
#pragma unroll 2
          for (int k4 = 0; k4 < 32; ++k4) {
              const f32x4 w0 = *(const f32x4*)(W + (size_t)(4 * k4 + 0) * NMOD), w1 = *(const f32x4*)(W + (size_t)(4 * k4 + 1) * NMOD),
                          w2 = *(const f32x4*)(W + (size_t)(4 * k4 + 2) * NMOD), w3 = *(const f32x4*)(W + (size_t)(4 * k4 + 3) * NMOD);
#pragma unroll
              for (int r = 0; r < 9; ++r) { const f32x4 s4 = *(const LAS f32x4*)(sc + r * DM + ks * 128 + 4 * k4);
                  acc[r] = acc[r] + w0 * s4.x + w1 * s4.y + w2 * s4.z + w3 * s4.w; }
          }
#pragma unroll
          for (int r = 0; r < 9; ++r) *(f32x4*)(PART + (((size_t)ks * DEPTH + i) * 9 + r) * NMOD + col) = acc[r];
      } }
    if (blockIdx.x == 0) {
        float* cosT = (float*)(ws + WS_TAB + TAB_COS); float* sinT = (float*)(ws + WS_TAB + TAB_SIN); float* LB = (float*)(ws + WS_TAB + TAB_LB);
        for (int i = tid; i < 64 * 32; i += NWAVES * 64) { const int pos = i >> 5, f = i & 31; const float inv = powf(10000.0f, -(float)f / 32.0f); const float ang = (float)pos * inv;
            float sv, cv; sincosf(ang, &sv, &cv); cosT[i] = cv; sinT[i] = sv; }
        for (int i = tid; i < 2 * DM; i += NWAVES * 64) { const float l0 = ((const float*)(const GAS float*)ld_u64(PT, 13))[i], l1 = ((const float*)(const GAS float*)ld_u64(PT, 13))[2 * DM + i]; const float mx = fmaxf(l0, l1);
            const float e0 = expf(l0 - mx), e1 = expf(l1 - mx), g0 = e0 / (e0 + e1), g1 = e1 / (e0 + e1);
            LB[i] = g0 - g0; LB[2 * DM + i] = (g0 + g1) - g0; }
    }
    __syncthreads();
    LAS float* scr = (LAS float*)(lds + wave * 8448);
    constexpr int I_QKV = (DM / 64) * (NQKV / 32), I_WO = (DM / 64) * (DM / 32), I_UP = (DM / 64) * (DFF / 32), I_DN = (DFF / 64) * (DM / 32);
    constexpr int T0 = 2 * I_QKV, T1 = T0 + 2 * I_WO, T3 = T1, T4 = T3 + 4 * I_UP, T5 = T4 + 4 * I_DN;
    for (int it = gw; it < T5; it += NGW) {
        if (it < T0) { const int l = it / I_QKV, r = it % I_QKV; transpose_item(((const float*)(const GAS float*)ld_u64(PT, 8)) + (size_t)l * DM * NQKV, DM, NQKV, (bf16*)(ws + WS_WQKV) + (size_t)l * NQKV * DM, true, scr, r, lane); }
        else if (it < T1) { const int q = it - T0, l = q / I_WO, r = q % I_WO; transpose_item(((const float*)(const GAS float*)ld_u64(PT, 9)) + (size_t)l * DM * DM, DM, DM, (bf16*)(ws + WS_WAO) + (size_t)l * DM * DM, false, scr, r, lane); }
        else if (it < T4) { const int q = it - T3, l = q / I_UP, r = q % I_UP; transpose_item(((const float*)(const GAS float*)ld_u64(PT, 15)) + (size_t)l * DM * DFF, DM, DFF, (bf16*)(ws + WS_WUP) + (size_t)l * DFF * DM, false, scr, r, lane); }
        else { const int q = it - T4, l = q / I_DN, r = q % I_DN; transpose_item(((const float*)(const GAS float*)ld_u64(PT, 16)) + (size_t)l * DFF * DM, DFF, DM, (bf16*)(ws + WS_WDN) + (size_t)l * DM * DFF, false, scr, r, lane); }
    }
}


__device__ __forceinline__ void mod_reduce_phase(const float* PART, const float* bias, float* MOD, int tid, int bx, int G) {
    constexpr int TOT4 = DEPTH * 9 * NMOD / 4;
    for (int e = bx * (NWAVES * 64) + tid; e < TOT4; e += G * NWAVES * 64) {
        const int i = e / (9 * NMOD / 4), n4 = e % (NMOD / 4);
        f32x4 s = *(const f32x4*)(bias + (size_t)i * NMOD + 4 * n4);
#pragma unroll
        for (int ks = 0; ks < 16; ++ks) s = s + *(const GAS f32x4*)(PART + (size_t)ks * (DEPTH * 9 * NMOD) + 4 * (size_t)e);
        *(GAS f32x4*)(MOD + 4 * (size_t)e) = s;
    }
}
typedef _Float16 f16;
typedef _Float16 f16x8 __attribute__((ext_vector_type(8)));
__device__ __forceinline__ void norm_tail(const float (&v)[4][8], float ss, bf16* Hrow, const float* g, const float* sh, const float* scl, int lane) {
    const float rstd = rsqrtf(wave_sum(ss, lane) * (1.0f / DM) + NORM_EPS);
#pragma unroll
    for (int j = 0; j < 4; ++j) { const int c = 8 * (lane + 64 * j); v4u o;
#pragma unroll
        for (int hh = 0; hh < 2; ++hh) { const f32x4 gg = *(const f32x4*)(g + c + 4 * hh), s1 = *(const f32x4*)(scl + c + 4 * hh), s0 = *(const f32x4*)(sh + c + 4 * hh);
            const f32x4 x4 = (f32x4){v[j][4 * hh], v[j][4 * hh + 1], v[j][4 * hh + 2], v[j][4 * hh + 3]};
            const f32x4 y = ((x4 * rstd) * gg) * (s1 + 1.0f) + s0;
            if (hh == 0) { o.x = pk2(y.x, y.y); o.y = pk2(y.z, y.w); } else { o.z = pk2(y.x, y.y); o.w = pk2(y.z, y.w); } }
        *(GAS v4u*)(Hrow + c) = o; }
}
__device__ __forceinline__ void norm0_phase(const float* xl, const float* xc, f16* X, bf16* H, const float* g, const float* mod_i, int lane, int gw, int NGW) {
    for (int r = gw; r < MT; r += NGW) {
        const float* xr = r < ML ? xl + (size_t)r * DM : xc + (size_t)(r - ML) * DM;
        const int r9 = r < ML ? (r >> 11) : 8;
        const float* sh = mod_i + (size_t)r9 * NMOD; const float* scl = sh + DM;
        float v[4][8]; float ss = 0.f;
#pragma unroll
        for (int j = 0; j < 4; ++j) { const int c = 8 * (lane + 64 * j); const f32x4 a = *(const GAS f32x4*)(xr + c), b = *(const GAS f32x4*)(xr + c + 4); f16x8 h;
#pragma unroll
            for (int e = 0; e < 4; ++e) { v[j][e] = a[e]; v[j][4 + e] = b[e]; h[e] = (f16)a[e]; h[4 + e] = (f16)b[e]; }
            *(GAS f16x8*)(X + (size_t)r * DM + c) = h;
#pragma unroll
            for (int e = 0; e < 8; ++e) ss += v[j][e] * v[j][e]; }
        norm_tail(v, ss, H + (size_t)r * DM, g, sh, scl, lane);
    }
}
__device__ __forceinline__ void norm_phase(f16* X, bf16* H, const float* g, const float* mod_i, int shift_chunk, int nrows, int lane, int gw, int NGW,
                                           const f16* slab = nullptr, const float* gate_ctx = nullptr) {
    for (int r = gw; r < nrows; r += NGW) {
        f16* xr = X + (size_t)r * DM;
        const int r9 = r < ML ? (r >> 11) : 8;
        const float* sh = mod_i + (size_t)r9 * NMOD + shift_chunk * DM; const float* scl = sh + DM;
        float v[4][8]; float ss = 0.f;
        const bool fold = (slab != nullptr) && (r >= ML);
#pragma unroll
        for (int j = 0; j < 4; ++j) { const int c = 8 * (lane + 64 * j); const f16x8 xv = *(const GAS f16x8*)(xr + c);
#pragma unroll
            for (int e = 0; e < 8; ++e) v[j][e] = (float)xv[e];
            if (fold) { constexpr size_t PS_ = (size_t)MC * DM; f16x8 h;
                const size_t po = (size_t)(r - ML) * DM + c;
                const f16x8 p0 = *(const GAS f16x8*)(slab + po), p1 = *(const GAS f16x8*)(slab + PS_ + po), p2 = *(const GAS f16x8*)(slab + 2 * PS_ + po), p3 = *(const GAS f16x8*)(slab + 3 * PS_ + po);
                const f32x4 gc0 = *(const f32x4*)(gate_ctx + c), gc1 = *(const f32x4*)(gate_ctx + c + 4);
#pragma unroll
                for (int e = 0; e < 8; ++e) { const float p = (((float)p0[e] + (float)p1[e]) + (float)p2[e]) + (float)p3[e]; v[j][e] += (e < 4 ? gc0[e & 3] : gc1[e & 3]) * p; h[e] = (f16)v[j][e]; }
                *(GAS f16x8*)(xr + c) = h; }
#pragma unroll
            for (int e = 0; e < 8; ++e) ss += v[j][e] * v[j][e]; }
        norm_tail(v, ss, H + (size_t)r * DM, g, sh, scl, lane);
    }
}
__device__ __forceinline__ void readout_phase(const bf16* OF, const bf16* OB, const bf16* RG, const f16* gslab, const float* og, bf16* O, int nrows, int lane, int gw, int NGW) {
    const f32x4 g4 = *(const f32x4*)(og + ((4 * lane) & 127));
    typedef _Float16 f16x4 __attribute__((ext_vector_type(4)));
    for (int r = gw; r < nrows; r += NGW) {
#pragma unroll
        for (int j = 0; j < 8; ++j) { const size_t off = (size_t)r * DM + 4 * (lane + 64 * j);
            const unsigned long long f8 = *(const GAS unsigned long long*)(OF + off), b8 = *(const GAS unsigned long long*)(OB + off);
            f32x4 gr;
            if (r < ML) { const unsigned long long gw8 = *(const GAS unsigned long long*)(RG + off); const unsigned glo = (unsigned)gw8, ghi = (unsigned)(gw8 >> 32);
                gr = (f32x4){__uint_as_float(glo << 16), __uint_as_float(glo & 0xffff0000u), __uint_as_float(ghi << 16), __uint_as_float(ghi & 0xffff0000u)}; }
            else { const size_t po = (size_t)(r - ML) * DM + 4 * (lane + 64 * j); constexpr size_t PS_ = (size_t)MC * DM;
                const f16x4 p0 = *(const GAS f16x4*)(gslab + po), p1 = *(const GAS f16x4*)(gslab + PS_ + po), p2 = *(const GAS f16x4*)(gslab + 2 * PS_ + po), p3 = *(const GAS f16x4*)(gslab + 3 * PS_ + po);
#pragma unroll
                for (int e = 0; e < 4; ++e) gr[e] = (((float)p0[e] + (float)p1[e]) + (float)p2[e]) + (float)p3[e]; }
            const unsigned flo = (unsigned)f8, fhi = (unsigned)(f8 >> 32), blo = (unsigned)b8, bhi = (unsigned)(b8 >> 32);
            f32x4 s; s.x = __uint_as_float(flo << 16) + __uint_as_float(blo << 16); s.y = __uint_as_float(flo & 0xffff0000u) + __uint_as_float(blo & 0xffff0000u);
            s.z = __uint_as_float(fhi << 16) + __uint_as_float(bhi << 16); s.w = __uint_as_float(fhi & 0xffff0000u) + __uint_as_float(bhi & 0xffff0000u);
            float ss = (s.x * s.x + s.y * s.y) + (s.z * s.z + s.w * s.w);
#pragma unroll
            for (int o = 1; o < 32; o <<= 1) ss += xor_get(ss, lane, o);
            const float rstd = rsqrtf(ss * (1.0f / 128.0f) + NORM_EPS);
#pragma unroll
            for (int e = 0; e < 4; ++e) gr[e] = gr[e] * __builtin_amdgcn_rcpf(1.0f + __expf(-gr[e]));
            const float y0 = (s.x * rstd) * g4.x * gr.x, y1 = (s.y * rstd) * g4.y * gr.y, y2 = (s.z * rstd) * g4.z * gr.z, y3 = (s.w * rstd) * g4.w * gr.w;
            *(GAS unsigned long long*)(O + off) = (unsigned long long)pk2(y0, y1) | ((unsigned long long)pk2(y2, y3) << 32); }
    }
}
__device__ __forceinline__ void final_norm_phase(const f16* X, const float* g, float* out, int lane, int gw, int NGW) {
    for (int r = gw; r < ML; r += NGW) {
        float v[4][8]; float ss = 0.f;
#pragma unroll
        for (int j = 0; j < 4; ++j) { const f16x8 xv = *(const GAS f16x8*)(X + (size_t)r * DM + 8 * (lane + 64 * j));
#pragma unroll
            for (int e = 0; e < 8; ++e) { v[j][e] = (float)xv[e]; ss += v[j][e] * v[j][e]; } }
        const float rstd = rsqrtf(wave_sum(ss, lane) * (1.0f / DM) + NORM_EPS);
#pragma unroll
        for (int j = 0; j < 4; ++j) { const int c = 8 * (lane + 64 * j);
#pragma unroll
            for (int hh = 0; hh < 2; ++hh) { const f32x4 gg = *(const f32x4*)(g + c + 4 * hh);
                *(GAS f32x4*)(out + (size_t)r * DM + c + 4 * hh) = ((f32x4){v[j][4 * hh], v[j][4 * hh + 1], v[j][4 * hh + 2], v[j][4 * hh + 3]} * rstd) * gg; } }
    }
}

__device__ __forceinline__ unsigned long long ld_u64(volatile LAS unsigned* PT, int idx) {
    const unsigned lo = __builtin_amdgcn_readfirstlane(PT[2 * idx]), hi = __builtin_amdgcn_readfirstlane(PT[2 * idx + 1]);
    return ((unsigned long long)hi << 32) | lo;
}
#define PIN(i) ((const float*)(const GAS float*)ld_u64(PT, (i)))
#define PWS() ((unsigned char*)(GAS unsigned char*)ld_u64(PT, 19))
__global__ void __launch_bounds__(NWAVES * 64, 2) mk_fwd(KArgs args) {
    extern __shared__ __attribute__((aligned(16))) unsigned char lds[];
    LAS unsigned char* L = (LAS unsigned char*)lds;
    volatile LAS unsigned* MISC = (volatile LAS unsigned*)(L + MISC_OFF);
    volatile LAS unsigned* PT = (volatile LAS unsigned*)(L + MISC_OFF + 256);
    const int tid = threadIdx.x;
    for (int u = tid; u < (LDS_BYTES - LDSCTL_OFF) / 4; u += NWAVES * 64) ((LAS unsigned*)(L + LDSCTL_OFF))[u] = 0u;
    __syncthreads();
    if (tid == 0) {
#define PUT(i, p) do { const unsigned long long v_ = (unsigned long long)(p); PT[2 * (i)] = (unsigned)v_; PT[2 * (i) + 1] = (unsigned)(v_ >> 32); } while (0)
        PUT(0, args.in[0]); PUT(1, args.in[1]); PUT(2, args.in[2]); PUT(3, args.in[3]); PUT(4, args.in[4]); PUT(5, args.in[5]); PUT(6, args.in[6]); PUT(7, args.in[7]); PUT(8, args.in[8]);
        PUT(9, args.in[9]); PUT(10, args.in[10]); PUT(11, args.in[11]); PUT(12, args.in[12]); PUT(13, args.in[13]); PUT(14, args.in[14]); PUT(15, args.in[15]); PUT(16, args.in[16]);
        PUT(17, args.in[17]); PUT(18, args.out); PUT(19, args.ws); PT[40] = (unsigned)args.ph_lo; PT[41] = (unsigned)args.ph_hi;
#undef PUT
    }
    __syncthreads();
#define PH_LO() ((int)__builtin_amdgcn_readfirstlane(PT[40]))
#define PH_HI() ((int)__builtin_amdgcn_readfirstlane(PT[41]))
    if (PH_HI() - PH_LO() > 1) (void)xcd_barrier_post((unsigned*)((gu32*)(PWS() + WS_CTL) + CW_BAR), MISC + 8);
#define IN(k) (PH_LO() <= (k) && (k) < PH_HI())
#define SEAM(k) do { if ((k) + 1 < PH_HI()) { XcdBarrier b_; b_.bar = (unsigned*)((gu32*)(PWS() + WS_CTL) + CW_BAR); b_.x = xb_xcc_id(); b_.st = MISC + 8; xcd_barrier(b_); } } while (0)
#define GEO() int tid_g = threadIdx.x; asm volatile("" : "+v"(tid_g)); const int lane = tid_g & 63, wave = __builtin_amdgcn_readfirstlane(tid_g >> 6), G = gridDim.x, bx = blockIdx.x, \
                        vcu = (G % 8 == 0) ? (bx % 8) * (G / 8) + bx / 8 : bx, gw = vcu * NWAVES + wave, NGW = G * NWAVES; (void)lane; (void)gw; (void)NGW

    if (IN(0)) { GEO(); p0_prologue(PT, L, tid_g, lane, wave, gw, NGW); SEAM(0); }
    if (IN(1)) { GEO(); unsigned char* ws = PWS(); mod_reduce_phase((const float*)(ws + WS_U), PIN(5), (float*)(ws + WS_MOD), tid_g, bx, G); SEAM(1); }
    if (IN(2)) { GEO(); unsigned char* ws = PWS(); norm0_phase(PIN(0), PIN(2), (f16*)(ws + WS_X), (bf16*)(ws + WS_H), PIN(6), (const float*)(ws + WS_MOD), lane, gw, NGW); SEAM(2); }

    for (int Lr = 0; Lr < DEPTH; ++Lr) {
        const int pb = 3 + 8 * Lr;
        if ((Lr & 1) == 0) {
            if (IN(pb + 0)) {
                GEO(); unsigned char* ws = PWS(); const int jl = Lr >> 1;
                pg8::Gemm g{(const bf16*)(ws + WS_H), (const bf16*)(ws + WS_WQKV) + (size_t)jl * NQKV * DM, MT, NQKV, DM, DM}; pg8::StaticOrder S; S.init(MT, NQKV, G, bx);
                pg8::EpiQkv E{(bf16*)(ws + WS_MIX), (const float*)(ws + WS_TAB + TAB_COS), (const float*)(ws + WS_TAB + TAB_SIN)};
                pg8::gemm_phase<pg8::EpiQkv, pg8::StaticOrder, true, true>(L, g, S, E);
                { constexpr int NU = (MT / 256) * (NQKV / 256), I_RI = (DM / 64) * (NREC / 32), I_WO = (DM / 64) * (DM / 32);
                  const int first = NU % G, nid = G - first;
                  if (bx >= first) { LAS float* scr = (LAS float*)(L + wave * 8448);
                      for (int it = (bx - first) * NWAVES + wave; it < I_RI + I_WO; it += nid * NWAVES) {
                          if (it < I_RI) transpose_item(PIN(11) + (size_t)jl * DM * NREC, DM, NREC, (bf16*)(ws + WS_WRI) + (size_t)jl * NREC * DM, false, scr, it, lane);
                          else transpose_item(PIN(12) + (size_t)jl * DM * DM, DM, DM, (bf16*)(ws + WS_WRO) + (size_t)jl * DM * DM, false, scr, it - I_RI, lane); } } }
                SEAM(pb + 0);
            }
            if (IN(pb + 1)) {
                GEO(); unsigned char* ws = PWS(); const int jl = Lr >> 1;
                const bf16* QKV = (const bf16*)(ws + WS_MIX); bf16* Ob = (bf16*)(ws + WS_O); const float* sinkp = PIN(10) + jl * 16;
#ifndef REP_ATTN
#define REP_ATTN 1
#endif
                for (int rep_ = 0; rep_ < REP_ATTN; ++rep_) att::attn_units(QKV, Ob, sinkp, bx, G, (char*)lds);
                SEAM(pb + 1);
            }
        } else {
            if (IN(pb + 0)) {
                GEO(); unsigned char* ws = PWS(); const int jl = Lr >> 1;
                const bf16* Wri = (const bf16*)(ws + WS_WRI) + (size_t)jl * NREC * DM;
                pg8::Gemm g{(const bf16*)(ws + WS_H), Wri, MT, NREC, DM, DM}; pg8::RecOrder S; S.init(G, bx);
                pg8::EpiRec E{(bf16*)(ws + WS_RQ), (bf16*)(ws + WS_RV), (bf16*)(ws + WS_RG), (pg8::f16_t*)(ws + WS_LF), (const float*)(ws + WS_TAB + TAB_LB) + jl * 2 * DM, (size_t)MT * DM, jl == 0};
                pg8::gemm_phase<pg8::EpiRec, pg8::RecOrder, true, true>(L, g, S, E);
                if (Lr != DEPTH - 1) { pg8::Gemm g2{(const bf16*)(ws + WS_H), Wri + (size_t)(4 * DM) * DM, MT, DM, DM / 4, DM}; pg8::SplitKCtxOrder S2; S2.init(G, bx, DM / 4);
                    pg8::EpiPart E2{(pg8::f16_t*)(ws + WS_GSLAB), DM / 4};
                    pg8::gemm_phase<pg8::EpiPart, pg8::SplitKCtxOrder, true, true>(L, g2, S2, E2); }
                SEAM(pb + 0);
            }
            if (IN(pb + 1)) {
                GEO(); unsigned char* ws = PWS();
                for (int sid = bx; sid < 256; sid += G) { const int b = sid >> 5, h = (sid >> 1) & 15, dir = sid & 1;
                    scn::scan_seq<15>((const bf16*)(ws + WS_RQ), (const bf16*)(ws + WS_RV), (const f16*)(ws + WS_LF) + (size_t)dir * MT * DM, (bf16*)(ws + (dir ? WS_OB : WS_OF)), b, h, dir, (char*)lds);
                    __syncthreads();
#ifdef PROBE_MODE
                    scn::scan_seq<PROBE_MODE>((const bf16*)(ws + WS_RQ), (const bf16*)(ws + WS_RV), (const f16*)(ws + WS_LF) + (size_t)dir * MT * DM, (bf16*)(ws + (dir ? WS_OB : WS_OF)), b, h, dir, (char*)lds);
                    __syncthreads();
#endif
                }
                SEAM(pb + 1);
            }
            if (IN(pb + 2)) {
                GEO(); unsigned char* ws = PWS(); const int jl = Lr >> 1;
                readout_phase((const bf16*)(ws + WS_OF), (const bf16*)(ws + WS_OB), (const bf16*)(ws + WS_RG), (const f16*)(ws + WS_GSLAB), PIN(14) + jl * 128, (bf16*)(ws + WS_O), Lr == DEPTH - 1 ? ML : MT, lane, gw, NGW);
                SEAM(pb + 2);
            }
        }
        if (IN(pb + 3)) {
            GEO(); unsigned char* ws = PWS(); const int jl = Lr >> 1, Mrows = (Lr == DEPTH - 1) ? ML : MT;
            const bf16* Wt = (Lr & 1) ? (const bf16*)(ws + WS_WRO) + (size_t)jl * DM * DM : (const bf16*)(ws + WS_WAO) + (size_t)jl * DM * DM;
            pg8::Gemm g{(const bf16*)(ws + WS_O), Wt, ML, DM, DM, DM}; pg8::StaticOrder S; S.init(ML, DM, G, bx);
            pg8::EpiRes E{(pg8::f16_t*)(ws + WS_X), (const float*)(ws + WS_MOD) + (size_t)Lr * 9 * NMOD + 2 * DM};
            pg8::gemm_phase<pg8::EpiRes, pg8::StaticOrder, true, true>(L, g, S, E);
            if (Mrows == MT) { pg8::Gemm g2{(const bf16*)(ws + WS_O), Wt, MT, DM, DM / 4, DM}; pg8::SplitKCtxOrder S2; S2.init(G, bx, DM / 4);
                pg8::EpiPart E2{(pg8::f16_t*)(ws + WS_U), DM / 4};
                pg8::gemm_phase<pg8::EpiPart, pg8::SplitKCtxOrder, true, true>(L, g2, S2, E2); }
            SEAM(pb + 3);
        }
        if (IN(pb + 4)) { GEO(); unsigned char* ws = PWS();
            norm_phase((f16*)(ws + WS_X), (bf16*)(ws + WS_H), PIN(7) + Lr * DM, (const float*)(ws + WS_MOD) + (size_t)Lr * 9 * NMOD, 3, (Lr == DEPTH - 1) ? ML : MT, lane, gw, NGW,
                       (const f16*)(ws + WS_U), (const float*)(ws + WS_MOD) + ((size_t)Lr * 9 + 8) * NMOD + 2 * DM); SEAM(pb + 4); }
        if (IN(pb + 5)) {
            GEO(); unsigned char* ws = PWS(); const int Mrows = (Lr == DEPTH - 1) ? ML : MT;
            pg8::Gemm g{(const bf16*)(ws + WS_H), (const bf16*)(ws + WS_WUP) + (size_t)Lr * DFF * DM, Mrows, DFF, DM, DM}; pg8::StaticOrder S; S.init(Mrows, DFF, G, bx);
            pg8::EpiUp E{(bf16*)(ws + WS_U), DFF};
            pg8::gemm_phase<pg8::EpiUp, pg8::StaticOrder, true, true>(L, g, S, E);
            SEAM(pb + 5);
        }
        if (IN(pb + 6)) {
            GEO(); unsigned char* ws = PWS(); const int Mrows = (Lr == DEPTH - 1) ? ML : MT;
            const bf16* Wd = (const bf16*)(ws + WS_WDN) + (size_t)Lr * DM * DFF;
            pg8::Gemm g{(const bf16*)(ws + WS_U), Wd, ML, DM, DFF, DFF}; pg8::StaticOrder S; S.init(ML, DM, G, bx);
            pg8::EpiRes E{(pg8::f16_t*)(ws + WS_X), (const float*)(ws + WS_MOD) + (size_t)Lr * 9 * NMOD + 5 * DM};
            pg8::gemm_phase<pg8::EpiRes, pg8::StaticOrder, true, true>(L, g, S, E);
            if (Mrows == MT) { pg8::Gemm g2{(const bf16*)(ws + WS_U), Wd, MT, DM, DFF / 4, DFF}; pg8::SplitKCtxOrder S2; S2.init(G, bx, DFF / 4);
                pg8::EpiPart E2{(pg8::f16_t*)(ws + WS_O), DFF / 4};
                pg8::gemm_phase<pg8::EpiPart, pg8::SplitKCtxOrder, true, true>(L, g2, S2, E2); }
            SEAM(pb + 6);
        }
        if (IN(pb + 7)) {
            GEO(); unsigned char* ws = PWS(); f16* X = (f16*)(ws + WS_X);
            if (Lr != DEPTH - 1) norm_phase(X, (bf16*)(ws + WS_H), PIN(6) + (Lr + 1) * DM, (const float*)(ws + WS_MOD) + (size_t)(Lr + 1) * 9 * NMOD, 0, MT, lane, gw, NGW,
                                            (const f16*)(ws + WS_O), (const float*)(ws + WS_MOD) + ((size_t)Lr * 9 + 8) * NMOD + 5 * DM);
            else final_norm_phase(X, PIN(17), (float*)(GAS float*)ld_u64(PT, 18), lane, gw, NGW);
            SEAM(pb + 7);
        }
    }
#undef IN
#undef SEAM
#undef GEO
}

#ifndef MK_ONE_LAUNCH
#define MK_ONE_LAUNCH 1
#endif
extern "C" void kernel_launch(void* const* d_in, const int* in_sizes, int n_in, void* d_out, int out_size, void* d_ws, size_t ws_size, hipStream_t stream) {
    static int grid = 0;
    if (grid == 0) {
        if (n_in != 18 || in_sizes[0] != ML * DM || out_size != ML * DM || ws_size < WS_END) {
            fprintf(stderr, "kernel_launch: shape mismatch: n_in %d in0 %d out %d ws %zu (need %zu)\n", n_in, n_in > 0 ? in_sizes[0] : -1, out_size, ws_size, (size_t)WS_END); grid = -1; return; }
        int dev = 0, cus = 0, per_cu = 0;
        if (hipGetDevice(&dev) != hipSuccess || hipDeviceGetAttribute(&cus, hipDeviceAttributeMultiprocessorCount, dev) != hipSuccess) { fprintf(stderr, "kernel_launch: device query failed\n"); grid = -1; return; }
        if (hipFuncSetAttribute((const void*)mk_fwd, hipFuncAttributeMaxDynamicSharedMemorySize, LDS_BYTES) != hipSuccess) { fprintf(stderr, "kernel_launch: hipFuncSetAttribute failed\n"); grid = -1; return; }
        if (hipOccupancyMaxActiveBlocksPerMultiprocessor(&per_cu, (const void*)mk_fwd, NWAVES * 64, LDS_BYTES) != hipSuccess || per_cu < 1)
            fprintf(stderr, "kernel_launch: note: occupancy query reports %d workgroups per CU\n", per_cu);
        (void)hipGetLastError();
        grid = cus;
    }
    if (grid < 0) return;
    if (hipMemsetAsync((char*)d_ws + WS_CTL, 0, CTL_ZERO_BYTES, stream) != hipSuccess) { fprintf(stderr, "kernel_launch: memset failed\n"); return; }
    KArgs a{};
    for (int i = 0; i < 18; ++i) a.in[i] = (const float*)d_in[i];
    a.out = (float*)d_out; a.ws = (unsigned char*)d_ws;
#if MK_ONE_LAUNCH
    a.ph_lo = 0; a.ph_hi = N_PHASES;
    hipLaunchKernelGGL(mk_fwd, dim3(grid), dim3(NWAVES * 64), LDS_BYTES, stream, a);
#else
    for (int ph = 0; ph < N_PHASES; ++ph) {
        if (ph >= 3) { const int Lr = (ph - 3) / 8, s = (ph - 3) % 8; if ((Lr & 1) == 0 && s == 2) continue; }
        a.ph_lo = ph; a.ph_hi = ph + 1;
        hipLaunchKernelGGL(mk_fwd, dim3(grid), dim3(NWAVES * 64), LDS_BYTES, stream, a);
    }
#endif
    const hipError_t le = hipPeekAtLastError();
    if (le != hipSuccess) fprintf(stderr, "kernel_launch: launch failed: %s\n", hipGetErrorName(le));
}
```
